# Optimizing an MI355X kernel written in HIP

```python
import math
import jax
import jax.numpy as jnp
from jax import lax
import numpy as np

D_MODEL = 1024
BATCH = 16
SEQ = 2048
DEPTH = 4

CTX_LEN = 256
GRID_W = 64

CONV_W = 4
CONV_LEFT = 2

BRANCH_W = D_MODEL
N_BRANCH = 3

SSD_HEAD_DIM = 64
SSD_HEADS = BRANCH_W // SSD_HEAD_DIM
SSD_WIDTH = SSD_HEADS * SSD_HEAD_DIM
SSD_GROUPS = 4
SSD_STATE = 128
SSD_CONV_CH = SSD_WIDTH + 2 * SSD_GROUPS * SSD_STATE
SSD_CHUNK = 128
DT_MIN = 1e-3
DT_MAX = 1e-1

LRU_WIDTH = BRANCH_W
LRU_BLOCKS = 16
LRU_BLOCK = LRU_WIDTH // LRU_BLOCKS
LRU_C = 8.0

GLA_HEADS = 4
GLA_KEY = D_MODEL // 2
GLA_VAL = BRANCH_W
GLA_DK = GLA_KEY // GLA_HEADS
GLA_DV = GLA_VAL // GLA_HEADS
GLA_GATE_RANK = 16
GLA_TAU = 16.0
GLA_CHUNK = 64

D_FF = 2816
FFN_RES_W = 0.5

N_MOD = 9

ALPHA = (2.0 * DEPTH) ** 0.25
BETA = (8.0 * DEPTH) ** -0.25
NORM_EPS = 1e-5

IN_SIZES = (SSD_WIDTH, SSD_CONV_CH, 2 * SSD_HEADS,
            LRU_WIDTH, LRU_WIDTH,
            GLA_KEY, GLA_KEY, GLA_VAL, GLA_VAL, 2 * GLA_GATE_RANK,
            N_BRANCH * D_MODEL)
IN_TOTAL = sum(IN_SIZES)

kernel_name = 'hybrid_ssd_rglru_gla_prefix_dit'


def layer_norm(x, g, b):
    xf = x.astype(jnp.float32)
    mu = jnp.mean(xf, axis=-1, keepdims=True)
    var = jnp.mean(jnp.square(xf - mu), axis=-1, keepdims=True)
    return ((xf - mu) * lax.rsqrt(var + NORM_EPS)).astype(g.dtype) * g + b


def rms_norm(x, g):
    xf = x.astype(jnp.float32)
    return (xf * lax.rsqrt(jnp.mean(jnp.square(xf), axis=-1, keepdims=True) + NORM_EPS)).astype(g.dtype) * g


def modulate(h, shift, scale):
    return h * (1.0 + scale) + shift


def post_norm(h, y, gate, res_w, g, b):
    return layer_norm(ALPHA * h + res_w * gate * y, g, b)


def swiglu(u, w_up, w_down):
    a, v = jnp.split(u @ w_up, 2, axis=-1)
    return (jax.nn.silu(a) * v) @ w_down


def ffn_sublayer(h, m, j, w_up, w_down, g, b):
    u = modulate(h, m[:, :, 3 * j], m[:, :, 3 * j + 1])
    return post_norm(h, swiglu(u, w_up, w_down), m[:, :, 3 * j + 2], FFN_RES_W, g, b)


def line_conv(x, w, b, line):
    n_b, t, ch = x.shape
    xl = x.reshape(n_b, t // line, line, ch)
    xp = jnp.pad(xl, ((0, 0), (0, 0), (CONV_LEFT, CONV_W - 1 - CONV_LEFT), (0, 0)))
    y = b + xp[:, :, 0:line] * w[0]
    for k in range(1, CONV_W):
        y = y + xp[:, :, k:k + line] * w[k]
    return y.reshape(n_b, t, ch)


def raster_to_colmajor(x, rows):
    n_b, t, ch = x.shape
    return x.reshape(n_b, rows, GRID_W, ch).transpose(0, 2, 1, 3).reshape(n_b, t, ch)


def colmajor_to_raster(x, rows):
    n_b, t, ch = x.shape
    return x.reshape(n_b, GRID_W, rows, ch).transpose(0, 2, 1, 3).reshape(n_b, t, ch)


def direction(t, d):
    return jnp.flip(t, axis=1) if d else t


def linear_scan(a, b, h0):
    b = b.at[:, 0].add(a[:, 0] * h0)

    def combine(lhs, rhs):
        return lhs[0] * rhs[0], rhs[0] * lhs[1] + rhs[1]

    return lax.associative_scan(combine, (a, b), axis=1)[1]


def ssd_chunk_scan(x, dt, A, B, C, h0):
    n_b, t, n_h, p = x.shape
    n_g, n_s = B.shape[-2], B.shape[-1]
    q = SSD_CHUNK
    nc = t // q
    hg = n_h // n_g
    xs = (x * dt[..., None]).reshape(n_b, nc, q, n_g, hg, p)
    a = (dt * A).reshape(n_b, nc, q, n_g, hg).transpose(0, 1, 3, 4, 2)
    a_cs = jnp.cumsum(a, axis=-1)
    bc = B.reshape(n_b, nc, q, n_g, n_s)
    cc = C.reshape(n_b, nc, q, n_g, n_s)
    causal = jnp.tril(jnp.ones((q, q), dtype=bool))
    seg = a_cs[..., :, None] - a_cs[..., None, :]
    decay = jnp.exp(jnp.where(causal, seg, -jnp.inf))
    scores = jnp.einsum('bclgn,bcsgn->bcgls', cc, bc)
    y_diag = jnp.einsum('bcghls,bcsghp->bclghp', scores[:, :, :, None] * decay, xs)
    to_end = jnp.exp(a_cs[..., -1:] - a_cs).transpose(0, 1, 4, 2, 3)
    chunk_states = jnp.einsum('bclgn,bclghp->bcghpn', bc, xs * to_end[..., None])
    chunk_decay = jnp.exp(a_cs[..., -1])[..., None, None]
    h0g = h0.reshape(n_b, n_g, hg, p, n_s)
    s_after = linear_scan(chunk_decay, chunk_states, h0g)
    s_before = jnp.concatenate([h0g[:, None], s_after[:, :-1]], axis=1)
    from_start = jnp.exp(a_cs).transpose(0, 1, 4, 2, 3)[..., None]
    y_off = jnp.einsum('bclgn,bcghpn->bclghp', cc, s_before) * from_start
    return (y_diag + y_off).reshape(n_b, t, n_h, p), s_after[:, -1].reshape(n_b, n_h, p, n_s)


def gla_chunk_scan(q, k, v, log_a, s0):
    n_b, t, n_h, dk = q.shape
    dv = v.shape[-1]
    cl = GLA_CHUNK
    nc = t // cl
    q = q.reshape(n_b, nc, cl, n_h, dk)
    k = k.reshape(n_b, nc, cl, n_h, dk)
    v = v.reshape(n_b, nc, cl, n_h, dv)
    bcum = jnp.cumsum(log_a.reshape(n_b, nc, cl, n_h, dk), axis=2)
    b_last = bcum[:, :, -1]
    q_in = q * jnp.exp(bcum)
    k_in = k * jnp.exp(-bcum)
    causal = jnp.tril(jnp.ones((cl, cl), dtype=bool))
    att = jnp.where(causal, jnp.einsum('bclhd,bcshd->bchls', q_in, k_in), 0.0)
    o = jnp.einsum('bchls,bcshv->bclhv', att, v)
    k_st = k * jnp.exp(b_last[:, :, None] - bcum)
    d_state = jnp.einsum('bclhd,bclhv->bchdv', k_st, v)
    s_after = linear_scan(jnp.exp(b_last)[..., None], d_state, s0)
    s_before = jnp.concatenate([s0[:, None], s_after[:, :-1]], axis=1)
    o = o + jnp.einsum('bclhd,bchdv->bclhv', q_in, s_before)
    return o.reshape(n_b, t, n_h, dv), s_after[:, -1]


def ssd_mixer(pc, pl, line_lat, conv_w, conv_b, dt_bias, a_log, d_skip, norm_g):
    def prep(p, line):
        z, xbc, dt_raw = p
        n_b, t, _ = z.shape
        xbc = jax.nn.silu(line_conv(xbc, conv_w, conv_b, line)).astype(jnp.float32)
        xs, bs, cs = jnp.split(xbc, [SSD_WIDTH, SSD_WIDTH + SSD_GROUPS * SSD_STATE], axis=-1)
        return (z, xs.reshape(n_b, t, SSD_HEADS, SSD_HEAD_DIM),
                bs.reshape(n_b, t, SSD_GROUPS, SSD_STATE), cs.reshape(n_b, t, SSD_GROUPS, SSD_STATE),
                dt_raw.astype(jnp.float32))

    zc, xc, bc, cc, dtc = prep(pc, pc[0].shape[1])
    zl, xl, bl, cl, dtl = prep(pl, line_lat)
    h0 = jnp.zeros((xl.shape[0], SSD_HEADS, SSD_HEAD_DIM, SSD_STATE), jnp.float32)
    ys = []
    for d in range(2):
        A = -jnp.exp(a_log[d].astype(jnp.float32))
        cols = slice(d * SSD_HEADS, (d + 1) * SSD_HEADS)
        dtc_d = jax.nn.softplus(dtc[..., cols] + dt_bias[d])
        dtl_d = jax.nn.softplus(dtl[..., cols] + dt_bias[d])
        y_c, h_c = ssd_chunk_scan(direction(xc, d), direction(dtc_d, d), A, direction(bc, d), direction(cc, d), h0)
        y_l, _ = ssd_chunk_scan(direction(xl, d), direction(dtl_d, d), A, direction(bl, d), direction(cl, d), h_c)
        skip = d_skip[d].astype(jnp.float32)[:, None]
        ys.append((direction(y_c, d) + skip * xc, direction(y_l, d) + skip * xl))

    def out(y, z):
        n_b, t = z.shape[:2]
        return rms_norm(y.reshape(n_b, t, SSD_WIDTH) * jax.nn.silu(z.astype(jnp.float32)), norm_g)

    return out(ys[0][0] + ys[1][0], zc), out(ys[0][1] + ys[1][1], zl)


def rglru_mixer(pc, pl, line_lat, conv_w, conv_b, w_a, b_a, w_x, b_x, lam):
    xc_raw, gc = pc
    xl_raw, gl = pl
    xc = line_conv(xc_raw, conv_w, conv_b, xc_raw.shape[1]).astype(jnp.float32)
    xl = line_conv(xl_raw, conv_w, conv_b, line_lat).astype(jnp.float32)

    def coeffs(x, d):
        xb = x.reshape(x.shape[:-1] + (LRU_BLOCKS, LRU_BLOCK))
        r = jax.nn.sigmoid(jnp.einsum('btnk,nkj->btnj', xb, w_a[d]).reshape(x.shape) + b_a[d])
        i = jax.nn.sigmoid(jnp.einsum('btnk,nkj->btnj', xb, w_x[d]).reshape(x.shape) + b_x[d])
        log_a = -LRU_C * r * jax.nn.softplus(-lam[d])
        return jnp.exp(log_a), jnp.sqrt(-jnp.expm1(2.0 * log_a)) * (i * x)

    h0 = jnp.zeros((xl.shape[0], LRU_WIDTH), jnp.float32)
    hs = []
    for d in range(2):
        ac, bcoef = coeffs(direction(xc, d), d)
        al, blcoef = coeffs(direction(xl, d), d)
        h_c = linear_scan(ac, bcoef, h0)
        h_l = linear_scan(al, blcoef, h_c[:, -1])
        hs.append((direction(h_c, d), direction(h_l, d)))
    y_c = (hs[0][0] + hs[1][0]).astype(gc.dtype) * jax.nn.gelu(gc)
    y_l = (hs[0][1] + hs[1][1]).astype(gl.dtype) * jax.nn.gelu(gl)
    return y_c, y_l


def gla_mixer(pc, pl, w_gate, b_gate, norm_g):
    def prep(p):
        q, k, v, g, a_lr = p
        n_b, t, _ = q.shape
        qh = q.astype(jnp.float32).reshape(n_b, t, GLA_HEADS, GLA_DK) * (GLA_DK ** -0.5)
        kh = k.astype(jnp.float32).reshape(n_b, t, GLA_HEADS, GLA_DK)
        vh = v.astype(jnp.float32).reshape(n_b, t, GLA_HEADS, GLA_DV)
        return qh, kh, vh, g, a_lr

    def log_decay(a_lr, d):
        z = a_lr[..., d * GLA_GATE_RANK:(d + 1) * GLA_GATE_RANK] @ w_gate[d] + b_gate[d]
        return (jax.nn.log_sigmoid(z.astype(jnp.float32)) / GLA_TAU).reshape(a_lr.shape[:2] + (GLA_HEADS, GLA_DK))

    qc, kc, vc, gc, ac = prep(pc)
    ql, kl, vl, gl, al = prep(pl)
    s0 = jnp.zeros((ql.shape[0], GLA_HEADS, GLA_DK, GLA_DV), jnp.float32)
    os_ = []
    for d in range(2):
        o_c, s_c = gla_chunk_scan(direction(qc, d), direction(kc, d), direction(vc, d), direction(log_decay(ac, d), d), s0)
        o_l, _ = gla_chunk_scan(direction(ql, d), direction(kl, d), direction(vl, d), direction(log_decay(al, d), d), s_c)
        os_.append((direction(o_c, d), direction(o_l, d)))

    def out(o, g):
        n_b, t = g.shape[:2]
        return rms_norm(o, norm_g).reshape(n_b, t, GLA_VAL) * jax.nn.silu(g)

    return out(os_[0][0] + os_[1][0], gc), out(os_[0][1] + os_[1][1], gl)


def merge_branches(branches, gate_logits, w_branch, w_out):
    n_b, t, _ = gate_logits.shape
    gates = jax.nn.sigmoid(gate_logits.reshape(n_b, t, N_BRANCH, D_MODEL))
    m = gates[:, :, 0] * (branches[0] @ w_branch[0])
    for n in range(1, N_BRANCH):
        m = m + gates[:, :, n] * (branches[n] @ w_branch[n])
    return m @ w_out


def token_mixer(u_ctx, u_lat, line_lat, need_ctx, w_in, ssd_conv_w, ssd_conv_b, ssd_dt_bias, ssd_a_log, ssd_d,
                ssd_norm_g, lru_conv_w, lru_conv_b, lru_w_a, lru_b_a, lru_w_x, lru_b_x, lru_lam,
                gla_w_gate, gla_b_gate, gla_norm_g, w_branch, w_out):
    offsets = [int(o) for o in np.cumsum(IN_SIZES)[:-1]]
    pc = jnp.split(u_ctx @ w_in, offsets, axis=-1)
    pl = jnp.split(u_lat @ w_in, offsets, axis=-1)
    ssd_c, ssd_l = ssd_mixer(pc[0:3], pl[0:3], line_lat, ssd_conv_w, ssd_conv_b, ssd_dt_bias, ssd_a_log, ssd_d, ssd_norm_g)
    lru_c, lru_l = rglru_mixer(pc[3:5], pl[3:5], line_lat, lru_conv_w, lru_conv_b, lru_w_a, lru_b_a, lru_w_x, lru_b_x, lru_lam)
    gla_c, gla_l = gla_mixer(pc[5:10], pl[5:10], gla_w_gate, gla_b_gate, gla_norm_g)
    y_lat = merge_branches((ssd_l, lru_l, gla_l), pl[10], w_branch, w_out)
    y_ctx = merge_branches((ssd_c, lru_c, gla_c), pc[10], w_branch, w_out) if need_ctx else None
    return y_ctx, y_lat


def setup_inputs(seed: int = 0) -> dict:
    key = jax.random.key(seed)
    keys = list(jax.random.split(key, 40))

    def nrm(shape, scale):
        return jax.random.normal(keys.pop(), shape, jnp.float32) * scale

    def unif(shape, lo, hi):
        return jax.random.uniform(keys.pop(), shape, jnp.float32, lo, hi)

    L, D = DEPTH, D_MODEL
    dt = jnp.exp(unif((L, 2, SSD_HEADS), math.log(DT_MIN), math.log(DT_MAX)))
    a_pow = unif((L, 2, LRU_WIDTH), 0.9, 0.999)
    a_lru = a_pow ** (1.0 / LRU_C)
    return {
        'x': nrm((BATCH, SEQ, D), 1.0),
        'c': nrm((BATCH, D), 1.0),
        'ctx': nrm((BATCH, CTX_LEN, D), 1.0),
        'c_ctx': nrm((D,), 1.0),
        'w_ada': nrm((L, D, N_MOD * D), 0.5 * D ** -0.5),
        'b_ada': nrm((L, N_MOD * D), 0.01),
        'ln_g': 1.0 + nrm((L, 3, D), 0.02),
        'ln_b': nrm((L, 3, D), 0.02),
        'ffn_w_up': nrm((L, 2, D, 2 * D_FF), D ** -0.5),
        'ffn_w_down': nrm((L, 2, D_FF, D), BETA * D_FF ** -0.5),
        'w_in': nrm((L, D, IN_TOTAL), D ** -0.5),
        'ssd_conv_w': nrm((L, CONV_W, SSD_CONV_CH), CONV_W ** -0.5),
        'ssd_conv_b': nrm((L, SSD_CONV_CH), 0.02),
        'ssd_dt_bias': dt + jnp.log(-jnp.expm1(-dt)),
        'ssd_a_log': jnp.log(unif((L, 2, SSD_HEADS), 1.0, 16.0)),
        'ssd_d': 1.0 + nrm((L, 2, SSD_HEADS), 0.1),
        'ssd_norm_g': 1.0 + nrm((L, SSD_WIDTH), 0.02),
        'lru_conv_w': nrm((L, CONV_W, LRU_WIDTH), CONV_W ** -0.5),
        'lru_conv_b': nrm((L, LRU_WIDTH), 0.02),
        'lru_w_a': nrm((L, 2, LRU_BLOCKS, LRU_BLOCK, LRU_BLOCK), LRU_BLOCK ** -0.5),
        'lru_b_a': nrm((L, 2, LRU_WIDTH), 0.02),
        'lru_w_x': nrm((L, 2, LRU_BLOCKS, LRU_BLOCK, LRU_BLOCK), LRU_BLOCK ** -0.5),
        'lru_b_x': nrm((L, 2, LRU_WIDTH), 0.02),
        'lru_lam': jnp.log(a_lru) - jnp.log1p(-a_lru),
        'gla_w_gate': nrm((L, 2, GLA_GATE_RANK, GLA_KEY), GLA_GATE_RANK ** -0.5),
        'gla_b_gate': nrm((L, 2, GLA_KEY), 0.02),
        'gla_norm_g': 1.0 + nrm((L, GLA_DV), 0.02),
        'w_branch': nrm((L, N_BRANCH, BRANCH_W, D), BRANCH_W ** -0.5),
        'w_out': nrm((L, D, D), BETA * D ** -0.5),
    }


def reference(x, c, ctx, c_ctx, w_ada, b_ada, ln_g, ln_b, ffn_w_up, ffn_w_down, w_in, ssd_conv_w, ssd_conv_b,
              ssd_dt_bias, ssd_a_log, ssd_d, ssd_norm_g, lru_conv_w, lru_conv_b, lru_w_a, lru_b_a, lru_w_x, lru_b_x,
              lru_lam, gla_w_gate, gla_b_gate, gla_norm_g, w_branch, w_out):
    n_b, t_lat, _ = x.shape
    rows = t_lat // GRID_W
    s_lat = jax.nn.silu(c)
    s_ctx = jax.nn.silu(c_ctx)
    for l in range(DEPTH):
        last = l == DEPTH - 1
        m_lat = (s_lat @ w_ada[l] + b_ada[l]).reshape(n_b, 1, N_MOD, D_MODEL)
        m_ctx = (s_ctx @ w_ada[l] + b_ada[l]).reshape(1, 1, N_MOD, D_MODEL)
        x = ffn_sublayer(x, m_lat, 0, ffn_w_up[l, 0], ffn_w_down[l, 0], ln_g[l, 0], ln_b[l, 0])
        ctx = ffn_sublayer(ctx, m_ctx, 0, ffn_w_up[l, 0], ffn_w_down[l, 0], ln_g[l, 0], ln_b[l, 0])
        u_lat = modulate(x, m_lat[:, :, 3], m_lat[:, :, 4])
        u_ctx = modulate(ctx, m_ctx[:, :, 3], m_ctx[:, :, 4])
        col_major = l % 2 == 1
        line = rows if col_major else GRID_W
        if col_major:
            u_lat = raster_to_colmajor(u_lat, rows)
        y_ctx, y_lat = token_mixer(u_ctx, u_lat, line, not last, w_in[l], ssd_conv_w[l], ssd_conv_b[l], ssd_dt_bias[l],
                                   ssd_a_log[l], ssd_d[l], ssd_norm_g[l], lru_conv_w[l], lru_conv_b[l], lru_w_a[l],
                                   lru_b_a[l], lru_w_x[l], lru_b_x[l], lru_lam[l], gla_w_gate[l], gla_b_gate[l],
                                   gla_norm_g[l], w_branch[l], w_out[l])
        if col_major:
            y_lat = colmajor_to_raster(y_lat, rows)
        x = post_norm(x, y_lat, m_lat[:, :, 5], 1.0, ln_g[l, 1], ln_b[l, 1])
        if not last:
            ctx = post_norm(ctx, y_ctx, m_ctx[:, :, 5], 1.0, ln_g[l, 1], ln_b[l, 1])
            ctx = ffn_sublayer(ctx, m_ctx, 2, ffn_w_up[l, 1], ffn_w_down[l, 1], ln_g[l, 2], ln_b[l, 2])
        x = ffn_sublayer(x, m_lat, 2, ffn_w_up[l, 1], ffn_w_down[l, 1], ln_g[l, 2], ln_b[l, 2])
    return x
```

```cpp
#include <hip/hip_runtime.h>
#include <hip/hip_cooperative_groups.h>
#include <cstdio>
namespace cg = cooperative_groups;

#define LAS __attribute__((address_space(3)))
typedef unsigned short bf16_t;
typedef short bf16x8 __attribute__((ext_vector_type(8)));
typedef float f32x4 __attribute__((ext_vector_type(4)));
typedef float f32x2 __attribute__((ext_vector_type(2)));
typedef unsigned u32x4 __attribute__((ext_vector_type(4)));
typedef unsigned u32x2 __attribute__((ext_vector_type(2)));

constexpr int DM = 1024, NBATCH = 16, SEQ = 2048, CTXL = 256, DEPTH = 4;
constexpr int TL = NBATCH * SEQ, TC = NBATCH * CTXL, TT = TL + TC;
constexpr int DFF = 2816, INTOT = 11328;
constexpr float ALPHA = 1.681792830507429f;
constexpr float EPS = 1e-5f;
constexpr int XCD_BAR_WORDS_C = 3456;

constexpr size_t WS_HCTX = 0;
constexpr size_t WS_MODS = WS_HCTX + (size_t)TC * DM * 4;
constexpr size_t WS_U    = WS_MODS + (size_t)DEPTH * 17 * 9216 * 4;
constexpr size_t WS_R    = WS_U + (size_t)TT * DM * 2;
constexpr size_t WS_YB   = WS_R + (size_t)TT * 3328 * 2;
constexpr size_t WS_BR   = WS_YB + (size_t)TT * DM * 4;
constexpr size_t BRSZ    = (size_t)TT * DM * 2;
constexpr size_t WS_WUP  = WS_BR + 3 * BRSZ;
constexpr size_t WS_WDN  = WS_WUP + (size_t)2 * 5632 * 1024 * 2;
constexpr size_t WS_WIN  = WS_WDN + (size_t)2 * 1024 * 2816 * 2;
constexpr size_t WS_WBR  = WS_WIN + (size_t)(INTOT + 256) * 1024 * 2;
constexpr size_t WS_WOUT = WS_WBR + (size_t)3 * 1024 * 1024 * 2;
constexpr size_t WS_WLRU = WS_WOUT + (size_t)1024 * 1024 * 2;
constexpr size_t WS_DTS  = WS_WLRU + (size_t)2 * 4096 * 256 * 2;
constexpr size_t WS_ALS  = WS_DTS + (size_t)TT * 32 * 4;
constexpr size_t WS_DTA  = WS_ALS + (size_t)TT * 32 * 4;
constexpr size_t WS_BAR  = WS_DTA + (size_t)TT * 32 * 2 * 4;
constexpr size_t WS_END  = WS_BAR + (size_t)XCD_BAR_WORDS_C * 4;

struct Params { const float* in[29]; float* out; unsigned char* ws; };
typedef const Params __attribute__((address_space(4)))* KP;
__device__ __forceinline__ KP kparams() { KP k = (KP)__builtin_amdgcn_kernarg_segment_ptr(); asm volatile("" : "+s"(k)); return k; }

typedef __bf16 bf16x2_t __attribute__((ext_vector_type(2)));
__device__ __forceinline__ unsigned cvt_pk_bf16(float lo, float hi) { bf16x2_t v; v.x = (__bf16)lo; v.y = (__bf16)hi; return __builtin_bit_cast(unsigned, v); }
__device__ __forceinline__ bf16_t f2bf(float f) { return __builtin_bit_cast(unsigned short, (__bf16)f); }
__device__ __forceinline__ float bflo(unsigned w) { return __uint_as_float(w << 16); }
__device__ __forceinline__ float bfhi(unsigned w) { return __uint_as_float(w & 0xffff0000u); }
__device__ __forceinline__ float bf2f(bf16_t b) { return __uint_as_float(((unsigned)b) << 16); }
__device__ __forceinline__ float sigm(float x) { return __builtin_amdgcn_rcpf(1.f + __expf(-x)); }
__device__ __forceinline__ float silu(float x) { return x * __builtin_amdgcn_rcpf(1.f + __expf(-x)); }
__device__ __forceinline__ float softplus(float x) { return fmaxf(x, 0.f) + log1pf(__expf(-fabsf(x))); }
__device__ __forceinline__ float gelu_tanh(float x) { const float u = 0.7978845608028654f * (x + 0.044715f * x * x * x); return x * (1.f - __builtin_amdgcn_rcpf(1.f + __expf(2.f * u))); }
__device__ __forceinline__ void unpack8(u32x4 w, float (&f)[8]) { f[0] = bflo(w.x); f[1] = bfhi(w.x); f[2] = bflo(w.y); f[3] = bfhi(w.y); f[4] = bflo(w.z); f[5] = bfhi(w.z); f[6] = bflo(w.w); f[7] = bfhi(w.w); }
__device__ __forceinline__ u32x4 pack8(const float (&f)[8]) { u32x4 w; w.x = cvt_pk_bf16(f[0], f[1]); w.y = cvt_pk_bf16(f[2], f[3]); w.z = cvt_pk_bf16(f[4], f[5]); w.w = cvt_pk_bf16(f[6], f[7]); return w; }
__device__ __forceinline__ float dppf(float v, const int ctrl_sel) {
    int r;
    if (ctrl_sel == 0) r = __builtin_amdgcn_update_dpp(0, __float_as_int(v), 0xB1, 0xF, 0xF, true);
    else if (ctrl_sel == 1) r = __builtin_amdgcn_update_dpp(0, __float_as_int(v), 0x4E, 0xF, 0xF, true);
    else if (ctrl_sel == 2) r = __builtin_amdgcn_update_dpp(0, __float_as_int(v), 0x141, 0xF, 0xF, true);
    else r = __builtin_amdgcn_update_dpp(0, __float_as_int(v), 0x140, 0xF, 0xF, true);
    return __int_as_float(r);
}
__device__ __forceinline__ float sum16(float v) { v += dppf(v, 0); v += dppf(v, 1); v += dppf(v, 2); v += dppf(v, 3); return v; }
__device__ __forceinline__ float wave_sum(float v, int lane) {
    v = sum16(v);
    v += __int_as_float(__builtin_amdgcn_ds_bpermute((lane ^ 16) << 2, __float_as_int(v)));
    v += __int_as_float(__builtin_amdgcn_ds_bpermute((lane ^ 32) << 2, __float_as_int(v)));
    return v;
}

__device__ __forceinline__ int obid() { int t = (int)blockIdx.x; asm volatile("" : "+s"(t)); return t; }
__device__ __forceinline__ int ogrid() { int t = (int)gridDim.x; asm volatile("" : "+s"(t)); return t; }
__device__ __forceinline__ int otid() { int t = (int)threadIdx.x; asm volatile("" : "+v"(t)); return t; }
__device__ __forceinline__ unsigned char* ows(KP p) { unsigned char* w = p->ws; asm volatile("" : "+s"(w)); return w; }
__device__ __forceinline__ int step_row(int b, int d, int s, int colmajor) {
    if (s < CTXL) { const int t = d ? (CTXL - 1 - s) : s; return TL + b * CTXL + t; }
    int q = s - CTXL; if (d) q = SEQ - 1 - q;
    const int tok = colmajor ? ((q & 31) * 64 + (q >> 5)) : q;
    return b * SEQ + tok;
}
__device__ __forceinline__ float* hrow(KP p, int row) { return row < TL ? p->out + (size_t)row * DM : (float*)(p->ws + WS_HCTX) + (size_t)(row - TL) * DM; }
__device__ __forceinline__ const float* modp(KP p, int l, int row, int idx) { const int r = row < TL ? (row >> 11) : 16; return (const float*)(p->ws + WS_MODS) + ((size_t)(l * 17 + r) * 9 + idx) * DM; }


#define XB_TMO      128
#define XB_XCNT(j)  (256  + 64 * (j))
#define XB_XSUB(j)  (1280 + 64 * (j))
#define XB_XGEN(j)  (2304 + 64 * (j))
#define XB_TOP      3328
#define XB_TOPGEN   3392
#define XB_SPIN_CAP (1u << 22)
__device__ __forceinline__ unsigned xb_ld(unsigned* q)              { return __hip_atomic_load(q, __ATOMIC_RELAXED, __HIP_MEMORY_SCOPE_AGENT); }
__device__ __forceinline__ unsigned xb_add(unsigned* q, unsigned v) { return __hip_atomic_fetch_add(q, v, __ATOMIC_RELAXED, __HIP_MEMORY_SCOPE_AGENT); }
__device__ __forceinline__ unsigned xb_xcc_id() { return (unsigned)__builtin_amdgcn_s_getreg((3 << 11) | 20) & 0xFu; }
#define XB_SPIN(cond, bar) do { unsigned _sp = 0; while (cond) { __builtin_amdgcn_s_sleep(1); \
    if ((++_sp & 255u) == 0u) { if (xb_ld(&(bar)[XB_TMO])) break; if (_sp > XB_SPIN_CAP) { atomicAdd(&(bar)[XB_TMO], 1u); break; } } } } while (0)
__device__ __forceinline__ void xcd_barrier_complete(unsigned* bar, unsigned x, unsigned& nloc, unsigned& nx) {
    const unsigned G = gridDim.x * gridDim.y * gridDim.z;
    unsigned sum, cnt, mine, sp = 0u;
    for (;;) {
        sum = 0u; cnt = 0u; mine = 0u;
#pragma unroll
        for (unsigned j = 0; j < 16; ++j) { const unsigned c = xb_ld(&bar[XB_XCNT(j)]); sum += c; cnt += (c > 0u) ? 1u : 0u; mine = (j == x) ? c : mine; }
        if (sum == G) break;
        __builtin_amdgcn_s_sleep(1);
        if ((++sp & 255u) == 0u) { if (xb_ld(&bar[XB_TMO])) break; if (sp > XB_SPIN_CAP) { atomicAdd(&bar[XB_TMO], 1u); break; } }
    }
    nloc = mine > 0u ? mine : 1u; nx = cnt > 0u ? cnt : 1u;
}
__device__ __forceinline__ void xcd_barrier(unsigned* bar, volatile LAS unsigned* st) {
    asm volatile("s_waitcnt vmcnt(0)" ::: "memory");
    __syncthreads();
    if (threadIdx.x == 0) {
        const unsigned x = xb_xcc_id();
        __builtin_amdgcn_s_waitcnt(0);
        unsigned nloc = st[0], nx = st[1];
        if (nloc == 0u) { xcd_barrier_complete(bar, x, nloc, nx); st[0] = nloc; st[1] = nx; }
        const unsigned old = xb_add(&bar[XB_XSUB(x)], 1u);
        const unsigned gen = old / nloc;
        if (old + 1u == (gen + 1u) * nloc) {
            __builtin_amdgcn_fence(__ATOMIC_RELEASE, "agent");
            asm volatile("s_waitcnt vmcnt(0)" ::: "memory");
            const unsigned og = xb_add(&bar[XB_TOP], 1u);
            const unsigned tg = og / nx;
            if (og + 1u == (tg + 1u) * nx) xb_add(&bar[XB_TOPGEN], 1u);
            else XB_SPIN(xb_ld(&bar[XB_TOPGEN]) == tg, bar);
            __builtin_amdgcn_fence(__ATOMIC_ACQUIRE, "agent");
            xb_add(&bar[XB_XGEN(x)], 1u);
            asm volatile("s_waitcnt vmcnt(0)" ::: "memory");
        } else {
            XB_SPIN(xb_ld(&bar[XB_XGEN(x)]) == gen, bar);
            __builtin_amdgcn_fence(__ATOMIC_ACQUIRE, "agent");
            asm volatile("s_waitcnt vmcnt(0)" ::: "memory");
        }
    }
    __syncthreads();
}

namespace pg8 {
constexpr int BM = 256, BK = 64, HALF = 128, HTB = HALF * BK * 2, STAGE_BYTES = 8 * HTB, NXCD = 8, WGM = 4;
__device__ __forceinline__ int lds_byte(int r, int c) { const int st = (r >> 4) * 2 + (c >> 5), rr = r & 15, cc = c & 31, ob = rr * 64 + cc * 2; return st * 1024 + (ob ^ (((ob >> 9) & 1) << 5)); }
__device__ __forceinline__ void stage_rc(int b, int& R, int& C) { const int st = b / 1024, sb = b % 1024, swz = sb ^ (((sb >> 9) & 1) << 5); R = (st >> 1) * 16 + swz / 64; C = (st & 1) * 32 + (swz % 64) / 2; }
__device__ __forceinline__ int perm32(int rho) { const int n = rho >> 4, i = rho & 15; return 8 * (i >> 2) + 4 * n + (i & 3); }
struct Unit { int pm, pn; };
struct Gemm { const bf16_t* A; const bf16_t* Bt; int M, N, K, lda, ldb, akoff; };
struct StaticOrder {
    int nM, nN, nwg, G, c;
    __device__ __forceinline__ void init(int M, int N, int G_, int c_) { nM = M / BM; nN = N / BM; nwg = nM * nN; G = G_; c = c_; }
    __device__ __forceinline__ bool next(int i, Unit& u) const {
        const long L = (long)i * G + c; if (L >= nwg) return false;
        int wgid = (int)L; { const int q = nwg / NXCD, r = nwg % NXCD, xcd = wgid % NXCD, off = wgid / NXCD; wgid = (xcd < r ? xcd * (q + 1) : r * (q + 1) + (xcd - r) * q) + off; }
        const int nig = WGM * nN, gid = wgid / nig, fm = gid * WGM, gsz = (nM - fm) < WGM ? (nM - fm) : WGM;
        u.pm = fm + ((wgid % nig) % gsz); u.pn = (wgid % nig) / gsz; return true;
    }
};

template <class Epi>
__device__ __forceinline__ void gemm_phase(LAS unsigned char* lds, const Gemm g, const StaticOrder& S, const Epi& E) {
    const int tid = otid(), wid = __builtin_amdgcn_readfirstlane(tid >> 6), lane = tid & 63, wr = wid >> 2, wc = wid & 3, fr = lane & 15, fq = lane >> 4;
    const int K = g.K, nt = K / BK;
    unsigned voffA[2], voffB[2];
#pragma unroll
    for (int i = 0; i < 2; ++i) { int R, C; stage_rc(tid * 16 + i * 8192, R, C); const int Rb = Epi::PERM ? ((R & ~31) + perm32(R & 31)) : R;
        voffA[i] = (unsigned)(R * g.lda + C) * 2u; voffB[i] = (unsigned)(Rb * g.ldb + C) * 2u; }
    const size_t kstep = (size_t)(BK * 2);
    const size_t hstepA = (size_t)HALF * g.lda * 2, hstepB = (size_t)HALF * g.ldb * 2;
    const size_t tstepA = 2 * hstepA, tstepB = 2 * hstepB;
    const unsigned ldsw = (unsigned)wid * 1024u;
    const int aoff = lds_byte(wr * 64 + fr, fq * 8), boff = lds_byte(wc * 32 + fr, fq * 8);
#define PG8_SA(b, h) (((b) * 2 + (h)) * HTB)
#define PG8_SB(b, h) ((4 + (b) * 2 + (h)) * HTB)
#define PG8_STAGE(bufoff, gbase, voff) do { _Pragma("unroll") for (int _i = 0; _i < 2; ++_i) \
        __builtin_amdgcn_global_load_lds((const unsigned*)((const char*)(gbase) + (voff)[_i]), (LAS unsigned*)(lds + (bufoff) + ldsw + _i * 8192), 16, 0, 0); } while (0)
#define PG8_LDA(dst, b, h) do { _Pragma("unroll") for (int m = 0; m < 4; ++m) _Pragma("unroll") for (int k = 0; k < 2; ++k) dst[m][k] = *(const LAS bf16x8*)(lds + PG8_SA(b, h) + aoff + m * 2048 + k * 1024); } while (0)
#define PG8_LDB(dst, b, h) do { _Pragma("unroll") for (int n = 0; n < 2; ++n) _Pragma("unroll") for (int k = 0; k < 2; ++k) dst[n][k] = *(const LAS bf16x8*)(lds + PG8_SB(b, h) + boff + n * 2048 + k * 1024); } while (0)
#define PG8_MMA(ai, bj, At, Bt) do { __builtin_amdgcn_s_setprio(1); _Pragma("unroll") for (int m = 0; m < 4; ++m) _Pragma("unroll") for (int n = 0; n < 2; ++n) _Pragma("unroll") for (int k = 0; k < 2; ++k) \
        acc[ai][bj][m][n] = __builtin_amdgcn_mfma_f32_16x16x32_bf16(Bt[n][k], At[m][k], acc[ai][bj][m][n], 0, 0, 0); __builtin_amdgcn_s_setprio(0); } while (0)
#define PG8_WAIT_V(n) asm volatile("s_waitcnt vmcnt(" #n ")" ::: "memory")
#define PG8_WAIT_L(n) asm volatile("s_waitcnt lgkmcnt(" #n ")" ::: "memory")
#define PG8_BAR __builtin_amdgcn_s_barrier()
#define PG8_SCHED __builtin_amdgcn_sched_barrier(0)
#define PG8_ABASE(u) ((const char*)g.A + (size_t)(u).pm * tstepA + (g.akoff ? (size_t)((u).pn >> 1) * 512 : (size_t)0))
#define PG8_BBASE(u) ((const char*)g.Bt + (size_t)(u).pn * tstepB)
    Unit cur, nxt; int ui = 0;
    if (!S.next(0, cur)) return;
    f32x4 acc[2][2][4][2];
#pragma unroll
    for (int a = 0; a < 2; ++a)
#pragma unroll
        for (int b = 0; b < 2; ++b)
#pragma unroll
            for (int m = 0; m < 4; ++m)
#pragma unroll
                for (int n = 0; n < 2; ++n) acc[a][b][m][n] = (f32x4){0.f, 0.f, 0.f, 0.f};
    bf16x8 At[4][2], B0[2][2], B1[2][2];
    const char* cA = PG8_ABASE(cur); const char* cB = PG8_BBASE(cur);
    PG8_STAGE(PG8_SB(0, 0), cB, voffB); PG8_STAGE(PG8_SA(0, 0), cA, voffA); PG8_STAGE(PG8_SB(0, 1), cB + hstepB, voffB); PG8_STAGE(PG8_SA(0, 1), cA + hstepA, voffA);
    if (wr == 1) PG8_BAR;
    PG8_WAIT_V(4); PG8_BAR;
    PG8_STAGE(PG8_SB(1, 0), cB + kstep, voffB); PG8_STAGE(PG8_SA(1, 0), cA + kstep, voffA); PG8_STAGE(PG8_SB(1, 1), cB + hstepB + kstep, voffB);
    PG8_WAIT_V(6); PG8_BAR;
    for (;;) {
        const bool has_next = S.next(ui + 1, nxt);
        const char* nA = has_next ? PG8_ABASE(nxt) : cA; const char* nB = has_next ? PG8_BBASE(nxt) : cB;
        for (int t = 0; t < nt; t += 2) {
            const bool last = (t == nt - 2);
            const char* a1 = cA + (size_t)(t + 1) * kstep;
            const char* a2 = last ? nA : cA + (size_t)(t + 2) * kstep; const char* b2 = last ? nB : cB + (size_t)(t + 2) * kstep;
            const char* a3 = a2 + kstep; const char* b3 = b2 + kstep;
            PG8_LDB(B0, 0, 0); PG8_SCHED; PG8_LDA(At, 0, 0); PG8_STAGE(PG8_SA(1, 1), a1 + hstepA, voffA);
            PG8_WAIT_L(8); PG8_BAR; PG8_WAIT_L(0); PG8_MMA(0, 0, At, B0); PG8_BAR; PG8_SCHED;
            PG8_LDB(B1, 0, 1); PG8_STAGE(PG8_SB(0, 0), b2, voffB);
            PG8_BAR; PG8_WAIT_L(0); PG8_MMA(0, 1, At, B1); PG8_BAR;
            PG8_LDA(At, 0, 1); PG8_STAGE(PG8_SA(0, 0), a2, voffA);
            PG8_BAR; PG8_WAIT_L(0); PG8_MMA(1, 0, At, B0); PG8_BAR; PG8_SCHED;
            PG8_STAGE(PG8_SB(0, 1), b2 + hstepB, voffB);
            PG8_WAIT_V(6); PG8_BAR; PG8_MMA(1, 1, At, B1); PG8_BAR;
            PG8_LDB(B0, 1, 0); PG8_SCHED; PG8_LDA(At, 1, 0); PG8_STAGE(PG8_SA(0, 1), a2 + hstepA, voffA);
            PG8_WAIT_L(8); PG8_BAR; PG8_WAIT_L(0); PG8_MMA(0, 0, At, B0); PG8_BAR; PG8_SCHED;
            PG8_LDB(B1, 1, 1); PG8_STAGE(PG8_SB(1, 0), b3, voffB);
            PG8_BAR; PG8_WAIT_L(0); PG8_MMA(0, 1, At, B1); PG8_BAR;
            PG8_LDA(At, 1, 1); PG8_STAGE(PG8_SA(1, 0), a3, voffA);
            PG8_BAR; PG8_WAIT_L(0); PG8_MMA(1, 0, At, B0); PG8_BAR; PG8_SCHED;
            PG8_STAGE(PG8_SB(1, 1), b3 + hstepB, voffB);
            PG8_WAIT_V(6); PG8_BAR; PG8_MMA(1, 1, At, B1); PG8_BAR;
        }
        E(acc, cur, wr, wc, fr, fq);
        if (!has_next) break;
#pragma unroll
        for (int a = 0; a < 2; ++a)
#pragma unroll
            for (int b = 0; b < 2; ++b)
#pragma unroll
                for (int m = 0; m < 4; ++m)
#pragma unroll
                    for (int n = 0; n < 2; ++n) acc[a][b][m][n] = (f32x4){0.f, 0.f, 0.f, 0.f};
        cur = nxt; cA = nA; cB = nB; ++ui;
    }
    PG8_WAIT_V(0);
    if (wr == 0) PG8_BAR;
    PG8_BAR;
#undef PG8_SA
#undef PG8_SB
#undef PG8_STAGE
#undef PG8_LDA
#undef PG8_LDB
#undef PG8_MMA
#undef PG8_WAIT_V
#undef PG8_WAIT_L
#undef PG8_BAR
#undef PG8_SCHED
#undef PG8_ABASE
#undef PG8_BBASE
}

struct EpiF32 {
    static constexpr bool PERM = false;
    float* C; int ldc;
    __device__ __forceinline__ void operator()(const f32x4 (&acc)[2][2][4][2], const Unit& u, int wr, int wc, int fr, int fq) const {
        const int row0 = u.pm * BM + wr * 64 + fr, col0 = u.pn * BM + wc * 32 + 4 * fq;
#pragma unroll
        for (int ai = 0; ai < 2; ++ai)
#pragma unroll
            for (int m = 0; m < 4; ++m) { float* rowp = C + (size_t)(row0 + ai * HALF + m * 16) * ldc + col0;
#pragma unroll
                for (int bj = 0; bj < 2; ++bj)
#pragma unroll
                    for (int n = 0; n < 2; ++n) *(f32x4*)(rowp + bj * HALF + n * 16) = acc[ai][bj][m][n]; }
    }
};
struct EpiBf16Side {
    static constexpr bool PERM = true;
    bf16_t* O; int ldc; float* side; int side_c0;
    __device__ __forceinline__ void operator()(const f32x4 (&acc)[2][2][4][2], const Unit& u, int wr, int wc, int fr, int fq) const {
        const int row0 = u.pm * BM + wr * 64 + fr, col0 = u.pn * BM + wc * 32 + 8 * fq;
#pragma unroll
        for (int ai = 0; ai < 2; ++ai)
#pragma unroll
            for (int m = 0; m < 4; ++m) { const int row = row0 + ai * HALF + m * 16; bf16_t* rowp = O + (size_t)row * ldc + col0;
#pragma unroll
                for (int bj = 0; bj < 2; ++bj) { const f32x4 v0 = acc[ai][bj][m][0], v1 = acc[ai][bj][m][1];
                    u32x4 w; w.x = cvt_pk_bf16(v0[0], v0[1]); w.y = cvt_pk_bf16(v0[2], v0[3]); w.z = cvt_pk_bf16(v1[0], v1[1]); w.w = cvt_pk_bf16(v1[2], v1[3]);
                    *(u32x4*)(rowp + bj * HALF) = w;
                    if (u.pn * BM + bj * HALF + wc * 32 == side_c0) { float* sp = side + (size_t)row * 32 + 8 * fq; *(f32x4*)sp = v0; *(f32x4*)(sp + 4) = v1; } } }
    }
};
struct EpiSwiglu {
    static constexpr bool PERM = true;
    bf16_t* O;
    __device__ __forceinline__ void operator()(const f32x4 (&acc)[2][2][4][2], const Unit& u, int wr, int wc, int fr, int fq) const {
        const int row0 = u.pm * BM + wr * 64 + fr, col0 = u.pn * HALF + wc * 32 + 8 * fq;
#pragma unroll
        for (int ai = 0; ai < 2; ++ai)
#pragma unroll
            for (int m = 0; m < 4; ++m) { const int row = row0 + ai * HALF + m * 16;
                float r[8];
#pragma unroll
                for (int n = 0; n < 2; ++n)
#pragma unroll
                    for (int j = 0; j < 4; ++j) r[n * 4 + j] = silu(acc[ai][0][m][n][j]) * acc[ai][1][m][n][j];
                *(u32x4*)(O + (size_t)row * DFF + col0) = pack8(r); }
    }
};
template <int NBR> struct EpiMerge {
    static constexpr bool PERM = true;
    const bf16_t* G; bf16_t* Y; bf16_t* Mo;
    __device__ __forceinline__ void operator()(const f32x4 (&acc)[2][2][4][2], const Unit& u, int wr, int wc, int fr, int fq) const {
        const int row0 = u.pm * BM + wr * 64 + fr, col0 = u.pn * BM + wc * 32 + 8 * fq;
#pragma unroll
        for (int ai = 0; ai < 2; ++ai)
#pragma unroll
            for (int m = 0; m < 4; ++m) { const int row = row0 + ai * HALF + m * 16;
#pragma unroll
                for (int bj = 0; bj < 2; ++bj) { const int col = col0 + bj * HALF;
                    float gl[8]; unpack8(*(const u32x4*)(G + (size_t)row * 3072 + NBR * 1024 + col), gl);
                    float v[8];
#pragma unroll
                    for (int n = 0; n < 2; ++n)
#pragma unroll
                        for (int j = 0; j < 4; ++j) v[n * 4 + j] = sigm(gl[n * 4 + j]) * acc[ai][bj][m][n][j];
                    bf16_t* yp = Y + (size_t)row * DM + col;
                    if (NBR > 0) { float y[8]; unpack8(*(const u32x4*)yp, y);
#pragma unroll
                        for (int j = 0; j < 8; ++j) v[j] += y[j]; }
                    if (NBR < 2) *(u32x4*)yp = pack8(v);
                    else *(u32x4*)(Mo + (size_t)row * DM + col) = pack8(v); } }
    }
};
struct EpiLru {
    static constexpr bool PERM = true;
    const float* ba; const float* bx; const float* lam;
    const bf16_t* X; bf16_t* LA; bf16_t* BV;
    __device__ __forceinline__ void operator()(const f32x4 (&acc)[2][2][4][2], const Unit& u, int wr, int wc, int fr, int fq) const {
        const int row0 = u.pm * BM + wr * 64 + fr, ch0 = u.pn * HALF + wc * 32 + 8 * fq;
#pragma unroll
        for (int n = 0; n < 2; ++n) {
            const int ch = ch0 + 4 * n;
            const f32x4 vba = *(const f32x4*)(ba + ch), vbx = *(const f32x4*)(bx + ch), vl = *(const f32x4*)(lam + ch);
            f32x4 vsp;
#pragma unroll
            for (int j = 0; j < 4; ++j) vsp[j] = -8.0f * softplus(-vl[j]);
#pragma unroll
            for (int ai = 0; ai < 2; ++ai)
#pragma unroll
                for (int m = 0; m < 4; ++m) { const int row = row0 + ai * HALF + m * 16;
                    const u32x2 xw = *(const u32x2*)(X + (size_t)row * DM + ch);
                    const float xv[4] = {bflo(xw.x), bfhi(xw.x), bflo(xw.y), bfhi(xw.y)};
                    float la[4], bb[4];
#pragma unroll
                    for (int j = 0; j < 4; ++j) {
                        const float r = sigm(acc[ai][0][m][n][j] + vba[j]), ig = sigm(acc[ai][1][m][n][j] + vbx[j]);
                        const float l_ = r * vsp[j];
                        la[j] = l_; bb[j] = sqrtf(fmaxf(1.0f - __expf(2.0f * l_), 0.f)) * ig * xv[j]; }
                    u32x2 w0, w1; w0.x = cvt_pk_bf16(la[0], la[1]); w0.y = cvt_pk_bf16(la[2], la[3]); w1.x = cvt_pk_bf16(bb[0], bb[1]); w1.y = cvt_pk_bf16(bb[2], bb[3]);
                    *(u32x2*)(LA + (size_t)row * DM + ch) = w0;
                    *(u32x2*)(BV + (size_t)row * DM + ch) = w1; }
        }
    }
};
}

__device__ __forceinline__ void phase_mods(KP p, LAS unsigned char* lds) {
    unsigned char* const ws = ows(p); const int BID_ = obid(), GRD_ = ogrid(); (void)ws; (void)BID_; (void)GRD_;
    LAS float* s = (LAS float*)lds;
    LAS float* red = s + 17 * 1024;
    const int tid = otid(), wid = tid >> 6, lane = tid & 63;
    const float* c = p->in[1]; const float* cctx = p->in[3];
    for (int i = tid; i < 17 * 1024; i += 512) { const float v = i < 16 * 1024 ? c[i] : cctx[i - 16 * 1024]; s[i] = silu(v); }
    __syncthreads();
    float* mods = (float*)(ws + WS_MODS);
    for (int item = BID_; item < DEPTH * 144; item += GRD_) {
        const int l = item / 144, n0 = (item % 144) * 64;
        const float* W = p->in[4] + (size_t)l * 1024 * 9216 + n0 + lane;
        float acc[17];
#pragma unroll
        for (int r = 0; r < 17; ++r) acc[r] = 0.f;
        const int k0 = wid * 128;
        for (int k = k0; k < k0 + 128; k += 4) {
            const float w0 = W[(size_t)k * 9216], w1 = W[(size_t)(k + 1) * 9216], w2 = W[(size_t)(k + 2) * 9216], w3 = W[(size_t)(k + 3) * 9216];
#pragma unroll
            for (int r = 0; r < 17; ++r) { const f32x4 sv = *(const LAS f32x4*)(s + r * 1024 + k); acc[r] += sv[0] * w0 + sv[1] * w1 + sv[2] * w2 + sv[3] * w3; }
        }
#pragma unroll
        for (int r = 0; r < 17; ++r) red[(wid * 17 + r) * 64 + lane] = acc[r];
        __syncthreads();
        for (int i = tid; i < 17 * 64; i += 512) { const int r = i >> 6, cc = i & 63; float sum = p->in[5][l * 9216 + n0 + cc];
#pragma unroll
            for (int w = 0; w < 8; ++w) sum += red[(w * 17 + r) * 64 + cc];
            mods[(size_t)(l * 17 + r) * 9216 + n0 + cc] = sum; }
        __syncthreads();
    }
}

__device__ __forceinline__ void phase_convert(KP p, int l, LAS unsigned char* lds) {
    unsigned char* const ws = ows(p); const int BID_ = obid(), GRD_ = ogrid(); (void)ws; (void)BID_; (void)GRD_;
    LAS float* tile = (LAS float*)lds;
    const int tid = otid(), c = tid & 63, r0 = tid >> 6;
    for (int t = BID_; t < 8080; t += GRD_) {
        const float* src; bf16_t* dst; int N, NT, dld, map = 0, idx;
        if (t < 2816) { const int w = t / 1408; idx = t % 1408; src = p->in[8] + (size_t)(l * 2 + w) * 1024 * 5632; N = 5632; NT = 88; dst = (bf16_t*)(ws + WS_WUP) + (size_t)w * 5632 * 1024; dld = 1024; map = 1; }
        else if (t < 4224) { const int w = (t - 2816) / 704; idx = (t - 2816) % 704; src = p->in[9] + (size_t)(l * 2 + w) * 2816 * 1024; N = 1024; NT = 16; dst = (bf16_t*)(ws + WS_WDN) + (size_t)w * 1024 * 2816; dld = 2816; }
        else if (t < 7056) { idx = t - 4224; src = p->in[10] + (size_t)l * 1024 * INTOT; N = INTOT; NT = 177; dst = (bf16_t*)(ws + WS_WIN); dld = 1024; }
        else if (t < 7824) { const int w = (t - 7056) / 256; idx = (t - 7056) % 256; src = p->in[27] + (size_t)(l * 3 + w) * 1024 * 1024; N = 1024; NT = 16; dst = (bf16_t*)(ws + WS_WBR) + (size_t)w * 1024 * 1024; dld = 1024; }
        else { idx = t - 7824; src = p->in[28] + (size_t)l * 1024 * 1024; N = 1024; NT = 16; dst = (bf16_t*)(ws + WS_WOUT); dld = 1024; }
        const int kt = idx / NT, nt = idx % NT;
#pragma unroll
        for (int i = 0; i < 2; ++i) { const int r = (tid >> 4) + 32 * i, c4 = (tid & 15) * 4;
            const f32x4 v = *(const f32x4*)(src + (size_t)(kt * 64 + r) * N + nt * 64 + c4);
            tile[r * 65 + c4] = v[0]; tile[r * 65 + c4 + 1] = v[1]; tile[r * 65 + c4 + 2] = v[2]; tile[r * 65 + c4 + 3] = v[3]; }
        __syncthreads();
        { const int nn = tid >> 3, k8 = (tid & 7) * 8; int n = nt * 64 + nn;
          if (map) { const int isv = n >= DFF, j = isv ? n - DFF : n; n = (j >> 7) * 256 + (isv ? 128 : 0) + (j & 127); }
          float f[8];
#pragma unroll
          for (int e = 0; e < 8; ++e) f[e] = tile[(k8 + e) * 65 + nn];
          *(u32x4*)(dst + (size_t)n * dld + kt * 64 + k8) = pack8(f); }
        __syncthreads();
    }
    bf16_t* wl = (bf16_t*)(ws + WS_WLRU);
    for (int i = BID_ * 512 + tid; i < 2 * 16 * 2 * 4096; i += GRD_ * 512) {
        const int k = i & 63, j = (i >> 6) & 63, gate = (i >> 12) & 1, blk = (i >> 13) & 15, d = i >> 17;
        wl[i] = f2bf((gate ? p->in[21] : p->in[19])[((size_t)((l * 2 + d) * 16 + blk)) * 4096 + k * 64 + j]);
    }
}

__device__ __forceinline__ void phase_init(KP p) {
    unsigned char* const ws = ows(p); const int BID_ = obid(), GRD_ = ogrid(); (void)ws; (void)BID_; (void)GRD_;
    const int tid_ = otid(); const int gw = BID_ * 8 + (tid_ >> 6), GW = GRD_ * 8, lane = tid_ & 63;
    bf16_t* U = (bf16_t*)(ws + WS_U);
    for (int row = gw; row < TT; row += GW) {
        const float* src = row < TL ? p->in[0] + (size_t)row * DM : p->in[2] + (size_t)(row - TL) * DM;
        float* h = hrow(p, row);
        const float* sh = modp(p, 0, row, 0); const float* sc = modp(p, 0, row, 1);
#pragma unroll
        for (int j = 0; j < 4; ++j) { const int col = j * 256 + lane * 4;
            const f32x4 v = *(const f32x4*)(src + col), a = *(const f32x4*)(sh + col), b = *(const f32x4*)(sc + col);
            *(f32x4*)(h + col) = v;
            u32x2 w; w.x = cvt_pk_bf16(v[0] * (1.f + b[0]) + a[0], v[1] * (1.f + b[1]) + a[1]); w.y = cvt_pk_bf16(v[2] * (1.f + b[2]) + a[2], v[3] * (1.f + b[3]) + a[3]);
            *(u32x2*)(U + (size_t)row * DM + col) = w; }
    }
}

__device__ __forceinline__ void phase_ln(KP p, int l, int gate_idx, float resw, int ln_idx, int nl, int nshift_idx, int nrows) {
    unsigned char* const ws = ows(p); const int BID_ = obid(), GRD_ = ogrid(); (void)ws; (void)BID_; (void)GRD_;
    const int tid_ = otid(); const int gw = BID_ * 8 + (tid_ >> 6), GW = GRD_ * 8, lane = tid_ & 63;
    bf16_t* U = (bf16_t*)(ws + WS_U);
    const bf16_t* Y = (const bf16_t*)(ws + WS_YB);
    const float* lg = p->in[6] + (size_t)(l * 3 + ln_idx) * DM; const float* lb = p->in[7] + (size_t)(l * 3 + ln_idx) * DM;
    for (int rp = gw; rp < nrows / 2; rp += GW) {
        const int row = rp * 2;
        float* h0 = hrow(p, row); float* h1 = h0 + DM;
        const float* gt = modp(p, l, row, gate_idx);
        f32x4 v[2][4]; float s0 = 0.f, s1 = 0.f;
#pragma unroll
        for (int j = 0; j < 4; ++j) { const int col = j * 256 + lane * 4;
            const f32x4 gv = resw * *(const f32x4*)(gt + col);
            const f32x4 ha = *(const f32x4*)(h0 + col), hb = *(const f32x4*)(h1 + col);
            const u32x2 yaw = *(const u32x2*)(Y + (size_t)row * DM + col), ybw = *(const u32x2*)(Y + (size_t)(row + 1) * DM + col);
            const f32x4 ya = (f32x4){bflo(yaw.x), bfhi(yaw.x), bflo(yaw.y), bfhi(yaw.y)}, yb = (f32x4){bflo(ybw.x), bfhi(ybw.x), bflo(ybw.y), bfhi(ybw.y)};
            v[0][j] = ALPHA * ha + gv * ya; v[1][j] = ALPHA * hb + gv * yb;
            s0 += v[0][j][0] + v[0][j][1] + v[0][j][2] + v[0][j][3]; s1 += v[1][j][0] + v[1][j][1] + v[1][j][2] + v[1][j][3]; }
        const float mu0 = wave_sum(s0, lane) * (1.f / DM), mu1 = wave_sum(s1, lane) * (1.f / DM);
        float q0 = 0.f, q1 = 0.f;
#pragma unroll
        for (int j = 0; j < 4; ++j) { v[0][j] = v[0][j] - mu0; v[1][j] = v[1][j] - mu1;
            q0 += v[0][j][0] * v[0][j][0] + v[0][j][1] * v[0][j][1] + v[0][j][2] * v[0][j][2] + v[0][j][3] * v[0][j][3];
            q1 += v[1][j][0] * v[1][j][0] + v[1][j][1] * v[1][j][1] + v[1][j][2] * v[1][j][2] + v[1][j][3] * v[1][j][3]; }
        const float r0 = rsqrtf(wave_sum(q0, lane) * (1.f / DM) + EPS), r1 = rsqrtf(wave_sum(q1, lane) * (1.f / DM) + EPS);
#pragma unroll
        for (int j = 0; j < 4; ++j) { const int col = j * 256 + lane * 4;
            const f32x4 g = *(const f32x4*)(lg + col), bb = *(const f32x4*)(lb + col);
            const f32x4 o0 = v[0][j] * r0 * g + bb, o1 = v[1][j] * r1 * g + bb;
            *(f32x4*)(h0 + col) = o0; *(f32x4*)(h1 + col) = o1;
            if (nl >= 0) { const f32x4 a = *(const f32x4*)(modp(p, nl, row, nshift_idx) + col), sc = 1.f + *(const f32x4*)(modp(p, nl, row, nshift_idx + 1) + col);
                u32x2 w; w.x = cvt_pk_bf16(o0[0] * sc[0] + a[0], o0[1] * sc[1] + a[1]); w.y = cvt_pk_bf16(o0[2] * sc[2] + a[2], o0[3] * sc[3] + a[3]);
                *(u32x2*)(U + (size_t)row * DM + col) = w;
                w.x = cvt_pk_bf16(o1[0] * sc[0] + a[0], o1[1] * sc[1] + a[1]); w.y = cvt_pk_bf16(o1[2] * sc[2] + a[2], o1[3] * sc[3] + a[3]);
                *(u32x2*)(U + (size_t)(row + 1) * DM + col) = w; } }
    }
}

__device__ __forceinline__ void conv_generic(KP p, int l, const bf16_t* src, int sld, int scol, bf16_t* dst, int nch, const float* cw, const float* cb, bool do_silu) {
    unsigned char* const ws = ows(p); const int BID_ = obid(), GRD_ = ogrid(); (void)ws; (void)BID_; (void)GRD_;
    const int colmajor = l & 1, ng = nch >> 3;
    const long total = (long)TT * ng, gstride = (long)GRD_ * 512;
    const int tid_ = otid();
    for (long it0 = (long)BID_ * 512 + tid_; it0 < total; it0 += 4 * gstride) {
        u32x4 xr[4][4]; int rowu[4], chu[4];
#pragma unroll
        for (int u = 0; u < 4; ++u) { const long it = it0 + u * gstride; const bool valid = it < total;
            const int row = valid ? (int)(it / ng) : 0, ch = valid ? (int)(it % ng) * 8 : 0;
            rowu[u] = valid ? row : -1; chu[u] = ch;
            int pos, len, stride;
            if (row < TL) { const int tok = row & (SEQ - 1); if (colmajor) { pos = tok >> 6; len = 32; stride = 64; } else { pos = tok & 63; len = 64; stride = 1; } }
            else { pos = (row - TL) & (CTXL - 1); len = CTXL; stride = 1; }
#pragma unroll
            for (int k = 0; k < 4; ++k) { const int dl = k - 2; u32x4 v = (u32x4){0u, 0u, 0u, 0u};
                if (valid && pos + dl >= 0 && pos + dl < len) v = *(const u32x4*)(src + (size_t)(row + dl * stride) * sld + scol + ch);
                xr[u][k] = v; } }
#pragma unroll
        for (int u = 0; u < 4; ++u) { if (rowu[u] < 0) continue;
            const int ch = chu[u];
            float acc[8];
            { const f32x4 b0 = *(const f32x4*)(cb + ch), b1 = *(const f32x4*)(cb + ch + 4);
#pragma unroll
              for (int e = 0; e < 4; ++e) { acc[e] = b0[e]; acc[4 + e] = b1[e]; } }
#pragma unroll
            for (int k = 0; k < 4; ++k) { float xv[8]; unpack8(xr[u][k], xv);
                const f32x4 w0 = *(const f32x4*)(cw + k * nch + ch), w1 = *(const f32x4*)(cw + k * nch + ch + 4);
#pragma unroll
                for (int e = 0; e < 4; ++e) { acc[e] += w0[e] * xv[e]; acc[4 + e] += w1[e] * xv[4 + e]; } }
            if (do_silu) {
#pragma unroll
                for (int e = 0; e < 8; ++e) acc[e] = silu(acc[e]); }
            *(u32x4*)(dst + (size_t)rowu[u] * nch + ch) = pack8(acc); }
    }
}
__device__ __forceinline__ void phase_ssd_conv(KP p, int l) {
    unsigned char* const ws = ows(p); const int BID_ = obid(), GRD_ = ogrid(); (void)ws; (void)BID_; (void)GRD_;
    const bf16_t* R = (const bf16_t*)(ws + WS_R);
    bf16_t* XC = (bf16_t*)(ws + WS_BR + BRSZ);
    conv_generic(p, l, R, 3328, 1024, XC, 2048, p->in[11] + (size_t)l * 4 * 2048, p->in[12] + (size_t)l * 2048, true);
    const float* DTS = (const float*)(ws + WS_DTS); f32x2* DTA = (f32x2*)(ws + WS_DTA);
    for (int i = BID_ * 512 + otid(); i < TT * 32; i += GRD_ * 512) {
        const int j = i & 31;
        const float dt = softplus(DTS[i] + p->in[13][l * 32 + j]);
        const float a = __expf(-dt * __expf(p->in[14][l * 32 + j]));
        DTA[i] = (f32x2){dt, a};
    }
}

__device__ __forceinline__ void phase_ssd_scan(KP p, int l, LAS unsigned char* lds) {
    unsigned char* const ws = ows(p); const int BID_ = obid(), GRD_ = ogrid(); (void)ws; (void)BID_; (void)GRD_;
    const int colmajor = l & 1;
    LAS float* xs = (LAS float*)lds;
    LAS float* Bs = xs + 2 * 32 * 128;
    LAS float* Cs = Bs + 2 * 32 * 128;
    LAS float* as_ = Cs + 2 * 32 * 128;
    LAS float* ys = as_ + 256;
    const int tid = otid(), wid = tid >> 6, lane = tid & 63, hh = wid >> 2, pq = wid & 3, pi = lane >> 4, ni = lane & 15;
    const bf16_t* XC = (const bf16_t*)(ws + WS_BR + BRSZ);
    const float* DTA = (const float*)(ws + WS_DTA);
    bf16_t* R = (bf16_t*)(ws + WS_R);
    for (int unit = BID_; unit < 256; unit += GRD_) {
        const int b = unit >> 4, d = (unit >> 3) & 1, g = (unit >> 1) & 3, half = unit & 1, head0 = g * 4 + half * 2;
        float H[4][8];
#pragma unroll
        for (int a = 0; a < 4; ++a)
#pragma unroll
            for (int c = 0; c < 8; ++c) H[a][c] = 0.f;
        u32x4 ldv[3]; f32x2 ldd = (f32x2){0.f, 0.f};
#define SSD_LOAD(chunk) do { _Pragma("unroll") for (int j = 0; j < 3; ++j) { const int idx = tid + j * 512, st = idx / 48, part = idx % 48; \
            const int row = step_row(b, d, (chunk) * 32 + st, colmajor); \
            const int col = part < 16 ? head0 * 64 + part * 8 : (part < 32 ? 1024 + g * 128 + (part - 16) * 8 : 1536 + g * 128 + (part - 32) * 8); \
            ldv[j] = *(const u32x4*)(XC + (size_t)row * 2048 + col); } \
        if (tid < 64) { const int row = step_row(b, d, (chunk) * 32 + (tid >> 1), colmajor); ldd = *(const f32x2*)(DTA + ((size_t)row * 32 + d * 16 + head0 + (tid & 1)) * 2); } } while (0)
#define SSD_STORE(buf) do { _Pragma("unroll") for (int j = 0; j < 3; ++j) { const int idx = tid + j * 512, st = idx / 48, part = idx % 48; \
            LAS float* dp = (part < 16 ? xs + part * 8 : (part < 32 ? Bs + (part - 16) * 8 : Cs + (part - 32) * 8)) + ((buf) * 32 + st) * 128; \
            float f[8]; unpack8(ldv[j], f); *(LAS f32x4*)dp = (f32x4){f[0], f[1], f[2], f[3]}; *(LAS f32x4*)(dp + 4) = (f32x4){f[4], f[5], f[6], f[7]}; } \
        if (tid < 64) *(LAS f32x2*)(as_ + (buf) * 128 + tid * 2) = ldd; } while (0)
        SSD_LOAD(0); SSD_STORE(0);
        __syncthreads();
        for (int c = 0; c < 72; ++c) {
            const int buf = c & 1;
            if (c + 1 < 72) SSD_LOAD(c + 1);
            for (int i = 0; i < 32; ++i) {
                const f32x2 da = *(const LAS f32x2*)(as_ + buf * 128 + (i * 2 + hh) * 2);
                const int rb = (buf * 32 + i) * 128;
                f32x4 xv = *(const LAS f32x4*)(xs + rb + hh * 64 + pq * 16 + pi * 4);
                const f32x4 b0 = *(const LAS f32x4*)(Bs + rb + ni * 8), b1 = *(const LAS f32x4*)(Bs + rb + ni * 8 + 4);
                const f32x4 c0 = *(const LAS f32x4*)(Cs + rb + ni * 8), c1 = *(const LAS f32x4*)(Cs + rb + ni * 8 + 4);
                xv = xv * da.x;
                const float a = da.y;
                float y[4];
#pragma unroll
                for (int pp = 0; pp < 4; ++pp) { float acc = 0.f;
#pragma unroll
                    for (int nn = 0; nn < 4; ++nn) { H[pp][nn] = a * H[pp][nn] + xv[pp] * b0[nn]; acc += c0[nn] * H[pp][nn]; }
#pragma unroll
                    for (int nn = 0; nn < 4; ++nn) { H[pp][4 + nn] = a * H[pp][4 + nn] + xv[pp] * b1[nn]; acc += c1[nn] * H[pp][4 + nn]; }
                    y[pp] = sum16(acc); }
                if (ni == 0) *(LAS f32x4*)(ys + i * 128 + hh * 64 + pq * 16 + pi * 4) = (f32x4){y[0], y[1], y[2], y[3]};
            }
            __syncthreads();
            { const int st = tid >> 4, part = tid & 15; const int row = step_row(b, d, c * 32 + st, colmajor);
              const f32x4 v0 = *(const LAS f32x4*)(ys + st * 128 + part * 8), v1 = *(const LAS f32x4*)(ys + st * 128 + part * 8 + 4);
              u32x4 w; w.x = cvt_pk_bf16(v0[0], v0[1]); w.y = cvt_pk_bf16(v0[2], v0[3]); w.z = cvt_pk_bf16(v1[0], v1[1]); w.w = cvt_pk_bf16(v1[2], v1[3]);
              *(u32x4*)(R + (size_t)row * 3328 + 1024 + d * 1024 + head0 * 64 + part * 8) = w; }
            if (c + 1 < 72) SSD_STORE(buf ^ 1);
            __syncthreads();
        }
#undef SSD_LOAD
#undef SSD_STORE
    }
}


__device__ __forceinline__ f32x4 mma16(const LAS bf16_t* A, int lda, int row0, const LAS bf16_t* Bt, int ldb, int col0, int ksteps, f32x4 acc, int lane) {
    const int r = lane & 15, q = lane >> 4;
    for (int kk = 0; kk < ksteps; ++kk) {
        const bf16x8 a = *(const LAS bf16x8*)(A + (row0 + r) * lda + kk * 32 + q * 8);
        const bf16x8 b = *(const LAS bf16x8*)(Bt + (col0 + r) * ldb + kk * 32 + q * 8);
        acc = __builtin_amdgcn_mfma_f32_16x16x32_bf16(a, b, acc, 0, 0, 0);
    }
    return acc;
}

__device__ __forceinline__ void phase_ssd_chunk(KP p, int l, LAS unsigned char* lds) {
    unsigned char* const ws = ows(p); const int BID_ = obid(), GRD_ = ogrid();
    const int colmajor = l & 1;
    LAS bf16_t* Cc = (LAS bf16_t*)lds;
    LAS bf16_t* Bc = Cc + 8704;
    LAS bf16_t* BT = Bc + 8704;
    LAS bf16_t* XT = BT + 9216;
    LAS bf16_t* Ms = XT + 9216;
    LAS bf16_t* Hs = Ms + 9216;
    LAS float* cs = (LAS float*)(lds + 124928);
    LAS float* dts = cs + 128;
    LAS bf16_t* Xn = Ms;
    const int tid = otid(), wid = tid >> 6, lane = tid & 63, r16 = lane & 15, quad = lane >> 4, hh = wid >> 2, wq = wid & 3;
    const bf16_t* XC = (const bf16_t*)(ws + WS_BR + BRSZ);
    const float* DTA = (const float*)(ws + WS_DTA);
    bf16_t* R = (bf16_t*)(ws + WS_R);
    for (int unit = BID_; unit < 256; unit += GRD_) {
        const int ux = unit & 7, uy = unit >> 3; const int b = uy >> 1, d = ux >> 2, g = ux & 3, half = uy & 1, head0 = g * 4 + half * 2;
        for (int i = tid; i < 8704; i += 512) ((LAS unsigned*)Hs)[i] = 0u;
        for (int i = tid; i < 4608; i += 512) ((LAS unsigned*)Ms)[i] = 0u;
        f32x4 Hacc[8];
#pragma unroll
        for (int i = 0; i < 8; ++i) Hacc[i] = (f32x4){0.f, 0.f, 0.f, 0.f};
        const float expAcs = __expf(p->in[14][l * 32 + d * 16 + head0 + (wid & 1)]);
        u32x4 ldv[6]; float dtn = 0.f;
#define SC_LOAD(chunk) do { _Pragma("unroll") for (int j = 0; j < 6; ++j) { const int idx = tid + j * 512, s_ = idx / 48, part = idx % 48; \
            const int row = step_row(b, d, (chunk) * 64 + s_, colmajor); \
            const int col = part < 16 ? head0 * 64 + part * 8 : (part < 32 ? 1024 + g * 128 + (part - 16) * 8 : 1536 + g * 128 + (part - 32) * 8); \
            ldv[j] = *(const u32x4*)(XC + (size_t)row * 2048 + col); } \
        if (wid < 2) { const int row = step_row(b, d, (chunk) * 64 + lane, colmajor); dtn = DTA[((size_t)row * 32 + d * 16 + head0 + wid) * 2]; } } while (0)
#define SC_STORE1() do { _Pragma("unroll") for (int j = 0; j < 6; ++j) { const int idx = tid + j * 512, s_ = idx / 48, part = idx % 48; \
            LAS bf16_t* dp = (part < 16 ? Xn + part * 8 : (part < 32 ? Bc + (part - 16) * 8 : Cc + (part - 32) * 8)) + s_ * 136; \
            *(LAS u32x4*)dp = ldv[j]; } \
        if (wid < 2) { dts[wid * 64 + lane] = dtn; float v = -dtn * expAcs; \
            _Pragma("unroll") for (int off = 1; off < 64; off <<= 1) { const float t_ = __int_as_float(__builtin_amdgcn_ds_bpermute((lane >= off ? lane - off : lane) << 2, __float_as_int(v))); if (lane >= off) v += t_; } \
            cs[wid * 64 + lane] = v; } } while (0)
#define SC_STORE2() do { _Pragma("unroll") for (int i = 0; i < 2; ++i) { const int id = tid + i * 512, prow = id & 127, s0 = (id >> 7) * 8; \
            float fx[8], fb[8]; \
            _Pragma("unroll") for (int e = 0; e < 8; ++e) { fx[e] = bf2f(Xn[(s0 + e) * 136 + prow]); fb[e] = bf2f(Bc[(s0 + e) * 136 + prow]); } \
            const f32x4 d0 = *(const LAS f32x4*)(dts + (prow >> 6) * 64 + s0), d1 = *(const LAS f32x4*)(dts + (prow >> 6) * 64 + s0 + 4); \
            _Pragma("unroll") for (int e = 0; e < 4; ++e) { fx[e] *= d0[e]; fx[4 + e] *= d1[e]; } \
            *(LAS u32x4*)(XT + prow * 72 + s0) = pack8(fx); *(LAS u32x4*)(BT + prow * 72 + s0) = pack8(fb); } } while (0)
        SC_LOAD(0); SC_STORE1();
        __syncthreads();
        SC_STORE2();
        __syncthreads();
        for (int c = 0; c < 36; ++c) {
            if (c + 1 < 36) SC_LOAD(c + 1);
            { const int lt = wid >> 1;
#pragma unroll
              for (int t2 = 0; t2 < 2; ++t2) { const int st = (wid & 1) * 2 + t2;
                  if (st <= lt) {
                      f32x4 acc = (f32x4){0.f, 0.f, 0.f, 0.f};
                      acc = mma16(Bc, 136, st * 16, Cc, 136, lt * 16, 4, acc, lane);
                      const int l_ = lt * 16 + r16, s0_ = st * 16 + quad * 4;
                      float csl[2], css[2][4];
#pragma unroll
                      for (int h2 = 0; h2 < 2; ++h2) { csl[h2] = cs[h2 * 64 + l_];
                          const f32x4 c4 = *(const LAS f32x4*)(cs + h2 * 64 + s0_); css[h2][0] = c4[0]; css[h2][1] = c4[1]; css[h2][2] = c4[2]; css[h2][3] = c4[3]; }
#pragma unroll
                      for (int h2 = 0; h2 < 2; ++h2) { float m[4];
#pragma unroll
                          for (int j = 0; j < 4; ++j) m[j] = (s0_ + j <= l_) ? acc[j] * __expf(csl[h2] - css[h2][j]) : 0.f;
                          u32x2 w; w.x = cvt_pk_bf16(m[0], m[1]); w.y = cvt_pk_bf16(m[2], m[3]);
                          *(LAS u32x2*)(Ms + (h2 * 64 + l_) * 72 + s0_) = w; } }
                  else { const int l_ = lt * 16 + r16, s0_ = st * 16 + quad * 4;
                      *(LAS u32x2*)(Ms + l_ * 72 + s0_) = (u32x2){0u, 0u}; *(LAS u32x2*)(Ms + (64 + l_) * 72 + s0_) = (u32x2){0u, 0u}; } } }
            __syncthreads();
            { const float e = __expf(cs[hh * 64 + wq * 16 + r16]);
              bf16x8 bc[4], bm[2];
#pragma unroll
              for (int kk = 0; kk < 4; ++kk) bc[kk] = *(const LAS bf16x8*)(Cc + (wq * 16 + r16) * 136 + kk * 32 + quad * 8);
#pragma unroll
              for (int kk = 0; kk < 2; ++kk) bm[kk] = *(const LAS bf16x8*)(Ms + (hh * 64 + wq * 16 + r16) * 72 + kk * 32 + quad * 8);
              const int row = step_row(b, d, c * 64 + wq * 16 + r16, colmajor);
              bf16_t* op = R + (size_t)row * 3328 + 1024 + d * 1024 + (head0 + hh) * 64 + quad * 4;
#pragma unroll
              for (int pt = 0; pt < 4; ++pt) { f32x4 a = (f32x4){0.f, 0.f, 0.f, 0.f};
#pragma unroll
                  for (int kk = 0; kk < 4; ++kk) a = __builtin_amdgcn_mfma_f32_16x16x32_bf16(*(const LAS bf16x8*)(Hs + (hh * 64 + pt * 16 + r16) * 136 + kk * 32 + quad * 8), bc[kk], a, 0, 0, 0);
                  a = a * e;
#pragma unroll
                  for (int kk = 0; kk < 2; ++kk) a = __builtin_amdgcn_mfma_f32_16x16x32_bf16(*(const LAS bf16x8*)(XT + (hh * 64 + pt * 16 + r16) * 72 + kk * 32 + quad * 8), bm[kk], a, 0, 0, 0);
                  u32x2 w; w.x = cvt_pk_bf16(a[0], a[1]); w.y = cvt_pk_bf16(a[2], a[3]);
                  *(u32x2*)(op + pt * 16) = w; } }
            __syncthreads();
            { const float cse = cs[hh * 64 + 63], dec = __expf(cse);
              bf16x8 aw[2];
#pragma unroll
              for (int kk = 0; kk < 2; ++kk) { const bf16x8 a = *(const LAS bf16x8*)(XT + (hh * 64 + wq * 16 + r16) * 72 + kk * 32 + quad * 8);
#pragma unroll
                  for (int e2 = 0; e2 < 8; ++e2) { const float w_ = __expf(cse - cs[hh * 64 + kk * 32 + quad * 8 + e2]);
                      aw[kk][e2] = (short)f2bf(bf2f((bf16_t)a[e2]) * w_); } }
#pragma unroll
              for (int nt = 0; nt < 8; ++nt) { f32x4 h = Hacc[nt] * dec;
#pragma unroll
                  for (int kk = 0; kk < 2; ++kk) { const bf16x8 bb = *(const LAS bf16x8*)(BT + (nt * 16 + r16) * 72 + kk * 32 + quad * 8);
                      h = __builtin_amdgcn_mfma_f32_16x16x32_bf16(aw[kk], bb, h, 0, 0, 0); }
                  Hacc[nt] = h; }
#pragma unroll
              for (int nt = 0; nt < 8; ++nt)
#pragma unroll
                  for (int j = 0; j < 4; ++j) Hs[(hh * 64 + wq * 16 + quad * 4 + j) * 136 + nt * 16 + r16] = f2bf(Hacc[nt][j]); }
            __syncthreads();
            if (c + 1 < 36) SC_STORE1();
            __syncthreads();
            if (c + 1 < 36) SC_STORE2();
            __syncthreads();
        }
#undef SC_LOAD
#undef SC_STORE1
#undef SC_STORE2
    }
}

__device__ __forceinline__ void phase_ssd_combine(KP p, int l) {
    unsigned char* const ws = ows(p); const int BID_ = obid(), GRD_ = ogrid(); (void)ws; (void)BID_; (void)GRD_;
    const int tid_ = otid(); const int gw = BID_ * 8 + (tid_ >> 6), GW = GRD_ * 8, lane = tid_ & 63;
    const bf16_t* R = (const bf16_t*)(ws + WS_R); const bf16_t* XC = (const bf16_t*)(ws + WS_BR + BRSZ);
    bf16_t* BR0 = (bf16_t*)(ws + WS_BR);
    const float* dsk = p->in[15] + l * 32; const float* ng = p->in[16] + (size_t)l * 1024;
    for (int rp = gw; rp < TT / 2; rp += GW) {
        f32x4 v[2][4]; float q[2] = {0.f, 0.f};
#pragma unroll
        for (int r = 0; r < 2; ++r) { const int row = rp * 2 + r;
#pragma unroll
            for (int j = 0; j < 4; ++j) { const int col = j * 256 + lane * 4, head = col >> 6;
                const u32x2 z = *(const u32x2*)(R + (size_t)row * 3328 + col), yf = *(const u32x2*)(R + (size_t)row * 3328 + 1024 + col), yb = *(const u32x2*)(R + (size_t)row * 3328 + 2048 + col);
                const u32x2 x = *(const u32x2*)(XC + (size_t)row * 2048 + col);
                const float dd = dsk[head] + dsk[16 + head];
                v[r][j][0] = (bflo(yf.x) + bflo(yb.x) + dd * bflo(x.x)) * silu(bflo(z.x));
                v[r][j][1] = (bfhi(yf.x) + bfhi(yb.x) + dd * bfhi(x.x)) * silu(bfhi(z.x));
                v[r][j][2] = (bflo(yf.y) + bflo(yb.y) + dd * bflo(x.y)) * silu(bflo(z.y));
                v[r][j][3] = (bfhi(yf.y) + bfhi(yb.y) + dd * bfhi(x.y)) * silu(bfhi(z.y));
                q[r] += v[r][j][0] * v[r][j][0] + v[r][j][1] * v[r][j][1] + v[r][j][2] * v[r][j][2] + v[r][j][3] * v[r][j][3]; } }
        const float rs0 = rsqrtf(wave_sum(q[0], lane) * (1.f / 1024.f) + EPS), rs1 = rsqrtf(wave_sum(q[1], lane) * (1.f / 1024.f) + EPS);
#pragma unroll
        for (int j = 0; j < 4; ++j) { const int col = j * 256 + lane * 4; const f32x4 g = *(const f32x4*)(ng + col);
            u32x2 w; w.x = cvt_pk_bf16(v[0][j][0] * rs0 * g[0], v[0][j][1] * rs0 * g[1]); w.y = cvt_pk_bf16(v[0][j][2] * rs0 * g[2], v[0][j][3] * rs0 * g[3]);
            *(u32x2*)(BR0 + (size_t)(rp * 2) * DM + col) = w;
            w.x = cvt_pk_bf16(v[1][j][0] * rs1 * g[0], v[1][j][1] * rs1 * g[1]); w.y = cvt_pk_bf16(v[1][j][2] * rs1 * g[2], v[1][j][3] * rs1 * g[3]);
            *(u32x2*)(BR0 + (size_t)(rp * 2 + 1) * DM + col) = w; }
    }
}
__device__ __forceinline__ void phase_lru_scan(KP p, int l, int d, LAS unsigned char* lds) {
    unsigned char* const ws = ows(p); const int BID_ = obid(), GRD_ = ogrid(); (void)ws; (void)BID_; (void)GRD_;
    const int colmajor = l & 1;
    LAS float* segE = (LAS float*)lds;
    LAS float* segL = segE + 512;
    const int tid = otid(), wid = tid >> 6, lane = tid & 63;
    const bf16_t* LA = (const bf16_t*)(ws + WS_YB); const bf16_t* BV = LA + (size_t)TT * DM;
    bf16_t* BR1 = (bf16_t*)(ws + WS_BR + BRSZ);
    const bf16_t* R = (const bf16_t*)(ws + WS_R);
    for (int unit = BID_; unit < 256; unit += GRD_) {
        const int b = unit >> 4, ch = (unit & 15) * 64 + lane;
        const int s0 = wid * 288;
        float h = 0.f, L = 0.f;
#pragma unroll 16
        for (int s = s0; s < s0 + 288; ++s) { const size_t o = (size_t)step_row(b, d, s, colmajor) * DM + ch;
            const float la = bf2f(LA[o]), bb = bf2f(BV[o]);
            h = __expf(la) * h + bb; L += la; }
        segE[wid * 64 + lane] = h; segL[wid * 64 + lane] = L;
        __syncthreads();
        h = 0.f;
        for (int w = 0; w < wid; ++w) h = __expf(segL[w * 64 + lane]) * h + segE[w * 64 + lane];
#pragma unroll 16
        for (int s = s0; s < s0 + 288; ++s) { const int row = step_row(b, d, s, colmajor); const size_t o = (size_t)row * DM + ch;
            const float la = bf2f(LA[o]), bb = bf2f(BV[o]);
            h = __expf(la) * h + bb;
            if (d == 0) BR1[o] = f2bf(h);
            else { const float gv = bf2f(R[(size_t)row * 2048 + 1024 + ch]); BR1[o] = f2bf((bf2f(BR1[o]) + h) * gelu_tanh(gv)); } }
        __syncthreads();
    }
}


__device__ __forceinline__ void phase_lru_fused(KP p, int l, LAS unsigned char* lds) {
    unsigned char* const ws = ows(p); const int BID_ = obid(), GRD_ = ogrid();
    const int colmajor = l & 1, linelat = colmajor ? 32 : 64;
    LAS bf16_t* raw = (LAS bf16_t*)lds;
    LAS bf16_t* xc  = raw + 4864;
    LAS bf16_t* wt  = xc + 4608;
    LAS float* as_ = (LAS float*)(lds + 37376);
    LAS float* bs_ = as_ + 8192;
    const int tid = otid(), wid = tid >> 6, lane = tid & 63, r16 = lane & 15, quad = lane >> 4, cs_ = tid >> 3, cg = tid & 7;
    const bf16_t* R = (const bf16_t*)(ws + WS_YB);
    bf16_t* BR1 = (bf16_t*)(ws + WS_BR + BRSZ);
    const bf16_t* WL = (const bf16_t*)(ws + WS_WLRU);
    for (int unit = BID_; unit < 256; unit += GRD_) {
        const int b = unit >> 4, blk = unit & 15, ch0 = blk * 64;
        float cwv[4][8], cbv[8];
#pragma unroll
        for (int e = 0; e < 8; ++e) { cbv[e] = p->in[18][l * 1024 + ch0 + cg * 8 + e];
#pragma unroll
            for (int k = 0; k < 4; ++k) cwv[k][e] = p->in[17][(size_t)(l * 4 + k) * 1024 + ch0 + cg * 8 + e]; }
#define LRU_ROW(isctx, q) ((isctx) ? TL + b * CTXL + (q) : b * SEQ + (colmajor ? (((q) & 31) * 64 + ((q) >> 5)) : (q)))
#define LRU_CHUNK(cc) const int isctx = (cc) < 4; const int oc = d ? (isctx ? 3 - (cc) : 35 - (cc)) : (isctx ? (cc) : (cc) - 4); const int q0 = oc * 64; const int seglen = isctx ? CTXL : SEQ;
#define LRU_LOAD(cc) do { LRU_CHUNK(cc) \
            _Pragma("unroll") for (int j = 0; j < 2; ++j) { const int idx = tid + j * 512; const int i_ = idx >> 3, kp = idx & 7; const int q = q0 - 2 + i_; \
                u32x4 v_ = (u32x4){0u, 0u, 0u, 0u}; \
                if (idx < 536 && q >= 0 && q < seglen) v_ = *(const u32x4*)(R + (size_t)LRU_ROW(isctx, q) * 2048 + ch0 + kp * 8); \
                ldx[j] = v_; } } while (0)
        for (int d = 0; d < 2; ++d) {
            __syncthreads();
            for (int i = tid; i < 1024; i += 512) { const int gate = i >> 9, j = (i >> 3) & 63, kp = i & 7;
                *(LAS u32x4*)(wt + (gate * 64 + j) * 72 + kp * 8) = *(const u32x4*)(WL + ((size_t)((d * 16 + blk) * 2 + gate)) * 4096 + j * 64 + kp * 8); }
            const int st = wid & 3, jt0 = (wid >> 2) * 2;
            float ba[2], bx[2], vsp[2];
#pragma unroll
            for (int e = 0; e < 2; ++e) { const int c_ = (l * 2 + d) * 1024 + ch0 + (jt0 + e) * 16 + r16;
                ba[e] = p->in[20][c_]; bx[e] = p->in[22][c_]; vsp[e] = -8.0f * softplus(-p->in[23][c_]); }
            float h = 0.f;
            u32x4 ldx[2];
            u32x4 hf_cur = (u32x4){0u, 0u, 0u, 0u}, g_cur = hf_cur, hf_nxt = hf_cur, g_nxt = hf_cur;
            LRU_LOAD(0);
            for (int cc = 0; cc <= 36; ++cc) {
                if (cc < 36) {
#pragma unroll
                    for (int j = 0; j < 2; ++j) { const int idx = tid + j * 512; if (idx < 536) *(LAS u32x4*)(raw + (idx >> 3) * 72 + (idx & 7) * 8) = ldx[j]; } }
                __syncthreads();
                if (cc < 36) {
                    LRU_CHUNK(cc)
                    if (cc + 1 < 36) LRU_LOAD(cc + 1);
                    if (d == 1) { const int rowo = LRU_ROW(isctx, q0 + cs_);
                        hf_nxt = *(const u32x4*)(BR1 + (size_t)rowo * DM + ch0 + cg * 8); g_nxt = *(const u32x4*)(R + (size_t)rowo * 2048 + 1024 + ch0 + cg * 8); }
                    if (wid != 0) {
                        const int line = isctx ? CTXL : linelat;
#pragma unroll
                        for (int rep = 0; rep < 2; ++rep) { const int item = rep ? tid + 384 : tid - 64;
                            if (rep == 0 || tid < 128) { const int cr = item >> 3, qme = q0 + cr;
                                float acc[8];
#pragma unroll
                                for (int e = 0; e < 8; ++e) acc[e] = cbv[e];
#pragma unroll
                                for (int k = 0; k < 4; ++k) { const int qq = qme + k - 2;
                                    if (qq >= 0 && qq < seglen && (qq & ~(line - 1)) == (qme & ~(line - 1))) { float xv[8]; unpack8(*(const LAS u32x4*)(raw + (cr + k) * 72 + cg * 8), xv);
#pragma unroll
                                        for (int e = 0; e < 8; ++e) acc[e] += cwv[k][e] * xv[e]; } }
                                *(LAS u32x4*)(xc + cr * 72 + cg * 8) = pack8(acc); } } } }
                if (wid == 0 && cc > 0) { LAS float* ap = as_ + ((cc - 1) & 1) * 4096; LAS float* bp = bs_ + ((cc - 1) & 1) * 4096;
                    for (int t0 = 0; t0 < 64; t0 += 16) { float av[16], bv[16];
#pragma unroll
                        for (int t = 0; t < 16; ++t) { const int s_ = d ? 63 - (t0 + t) : (t0 + t); av[t] = ap[s_ * 64 + lane]; bv[t] = bp[s_ * 64 + lane]; }
#pragma unroll
                        for (int t = 0; t < 16; ++t) { h = av[t] * h + bv[t]; bv[t] = h; }
#pragma unroll
                        for (int t = 0; t < 16; ++t) { const int s_ = d ? 63 - (t0 + t) : (t0 + t); bp[s_ * 64 + lane] = bv[t]; } } }
                __syncthreads();
                if (cc < 36) {
                    LAS float* ap = as_ + (cc & 1) * 4096; LAS float* bp = bs_ + (cc & 1) * 4096;
#pragma unroll
                    for (int e = 0; e < 2; ++e) { f32x4 ga = (f32x4){0.f, 0.f, 0.f, 0.f}, gx = (f32x4){0.f, 0.f, 0.f, 0.f};
                        ga = mma16(xc, 72, st * 16, wt, 72, (jt0 + e) * 16, 2, ga, lane);
                        gx = mma16(xc, 72, st * 16, wt + 64 * 72, 72, (jt0 + e) * 16, 2, gx, lane);
                        const int ch = (jt0 + e) * 16 + r16;
#pragma unroll
                        for (int j4 = 0; j4 < 4; ++j4) { const int s_ = st * 16 + quad * 4 + j4;
                            const float x_ = bf2f(xc[s_ * 72 + ch]);
                            const float r_ = sigm(ga[j4] + ba[e]), ig = sigm(gx[j4] + bx[e]);
                            const float a_ = __expf(r_ * vsp[e]);
                            ap[s_ * 64 + ch] = a_; bp[s_ * 64 + ch] = sqrtf(fmaxf(1.0f - a_ * a_, 0.f)) * ig * x_; } } }
                if (cc > 0) {
                    LRU_CHUNK(cc - 1)
                    (void)seglen;
                    const int rowo = LRU_ROW(isctx, q0 + cs_);
                    const LAS float* bp = bs_ + ((cc - 1) & 1) * 4096;
                    const f32x4 h0 = *(const LAS f32x4*)(bp + cs_ * 64 + cg * 8), h1 = *(const LAS f32x4*)(bp + cs_ * 64 + cg * 8 + 4);
                    float o[8] = {h0[0], h0[1], h0[2], h0[3], h1[0], h1[1], h1[2], h1[3]};
                    if (d == 1) { float hf[8], gg[8]; unpack8(hf_cur, hf); unpack8(g_cur, gg);
#pragma unroll
                        for (int e = 0; e < 8; ++e) o[e] = (hf[e] + o[e]) * gelu_tanh(gg[e]); }
                    *(u32x4*)(BR1 + (size_t)rowo * DM + ch0 + cg * 8) = pack8(o); }
                hf_cur = hf_nxt; g_cur = g_nxt;
            }
        }
#undef LRU_ROW
#undef LRU_CHUNK
#undef LRU_LOAD
    }
}

__device__ __forceinline__ void phase_gla_decay(KP p, int l) {
    unsigned char* const ws = ows(p); const int BID_ = obid(), GRD_ = ogrid(); (void)ws; (void)BID_; (void)GRD_;
    const int tid_ = otid(); const int gw = BID_ * 8 + (tid_ >> 6), GW = GRD_ * 8, lane = tid_ & 63;
    const float* ALS = (const float*)(ws + WS_ALS);
    bf16_t* LAg = (bf16_t*)(ws + WS_YB);
    for (int it = gw; it < TT * 2; it += GW) {
        const int row = it >> 1, d = it & 1, c0 = lane * 8;
        const float* wg = p->in[24] + (size_t)(l * 2 + d) * 16 * 512; const float* bg = p->in[25] + (size_t)(l * 2 + d) * 512;
        float acc[8];
#pragma unroll
        for (int e = 0; e < 8; ++e) acc[e] = bg[c0 + e];
#pragma unroll
        for (int r = 0; r < 16; ++r) { const float a = ALS[(size_t)row * 32 + d * 16 + r];
            const f32x4 w0 = *(const f32x4*)(wg + r * 512 + c0), w1 = *(const f32x4*)(wg + r * 512 + c0 + 4);
#pragma unroll
            for (int e = 0; e < 4; ++e) { acc[e] += a * w0[e]; acc[4 + e] += a * w1[e]; } }
#pragma unroll
        for (int e = 0; e < 8; ++e) acc[e] = -softplus(-acc[e]) * (1.f / 16.f);
        *(u32x4*)(LAg + ((size_t)d * TT + row) * 512 + c0) = pack8(acc);
    }
}

__device__ __forceinline__ void phase_gla_scan(KP p, int l, LAS unsigned char* lds) {
    unsigned char* const ws = ows(p); const int BID_ = obid(), GRD_ = ogrid(); (void)ws; (void)BID_; (void)GRD_;
    const int colmajor = l & 1;
    LAS float* qs = (LAS float*)lds;
    LAS float* ks = qs + 2 * 16 * 128;
    LAS float* vs = ks + 2 * 16 * 128;
    LAS float* al = vs + 2 * 16 * 128;
    LAS float* os = al + 2 * 16 * 128;
    const int tid = otid(), wid = tid >> 6, lane = tid & 63, kg = lane & 15, vg = wid * 4 + (lane >> 4);
    const bf16_t* R = (const bf16_t*)(ws + WS_R);
    const bf16_t* LAg = (const bf16_t*)(ws + WS_YB);
    for (int unit = BID_; unit < 256; unit += GRD_) {
        const int b = unit >> 4, d = (unit >> 3) & 1, head = (unit >> 1) & 3, vh = unit & 1;
        bf16_t* O = d ? (bf16_t*)(ws + WS_YB + BRSZ) : (bf16_t*)(ws + WS_BR + 2 * BRSZ);
        float S[8][4];
#pragma unroll
        for (int a = 0; a < 8; ++a)
#pragma unroll
            for (int c = 0; c < 4; ++c) S[a][c] = 0.f;
        u32x4 ldv[2];
#define GLA_LOAD(chunk) do { _Pragma("unroll") for (int j = 0; j < 2; ++j) { const int idx = tid + j * 512, st = idx >> 6, part = idx & 63, which = part >> 4, pp = part & 15; \
            const int row = step_row(b, d, (chunk) * 16 + st, colmajor); \
            const bf16_t* sp = which == 0 ? R + (size_t)row * 3328 + head * 128 + pp * 8 : (which == 1 ? R + (size_t)row * 3328 + 512 + head * 128 + pp * 8 : \
                (which == 2 ? R + (size_t)row * 3328 + 1024 + head * 256 + vh * 128 + pp * 8 : LAg + ((size_t)d * TT + row) * 512 + head * 128 + pp * 8)); \
            ldv[j] = *(const u32x4*)sp; } } while (0)
#define GLA_STORE(buf) do { _Pragma("unroll") for (int j = 0; j < 2; ++j) { const int idx = tid + j * 512, st = idx >> 6, part = idx & 63, which = part >> 4, pp = part & 15; \
            LAS float* dp = (which == 0 ? qs : (which == 1 ? ks : (which == 2 ? vs : al))) + ((buf) * 16 + st) * 128 + pp * 8; \
            float f[8]; unpack8(ldv[j], f); \
            if (which == 0) { _Pragma("unroll") for (int e = 0; e < 8; ++e) f[e] *= 0.08838834764831845f; } \
            if (which == 3) { _Pragma("unroll") for (int e = 0; e < 8; ++e) f[e] = __expf(f[e]); } \
            *(LAS f32x4*)dp = (f32x4){f[0], f[1], f[2], f[3]}; *(LAS f32x4*)(dp + 4) = (f32x4){f[4], f[5], f[6], f[7]}; } } while (0)
        GLA_LOAD(0); GLA_STORE(0);
        __syncthreads();
        for (int c = 0; c < 144; ++c) {
            const int buf = c & 1;
            if (c + 1 < 144) GLA_LOAD(c + 1);
            for (int i = 0; i < 16; ++i) {
                const int rb = (buf * 16 + i) * 128;
                const f32x4 a0 = *(const LAS f32x4*)(al + rb + kg * 8), a1 = *(const LAS f32x4*)(al + rb + kg * 8 + 4);
                const f32x4 k0 = *(const LAS f32x4*)(ks + rb + kg * 8), k1 = *(const LAS f32x4*)(ks + rb + kg * 8 + 4);
                const f32x4 q0 = *(const LAS f32x4*)(qs + rb + kg * 8), q1 = *(const LAS f32x4*)(qs + rb + kg * 8 + 4);
                const f32x4 vv = *(const LAS f32x4*)(vs + rb + vg * 4);
                float o[4] = {0.f, 0.f, 0.f, 0.f};
#pragma unroll
                for (int kk = 0; kk < 4; ++kk)
#pragma unroll
                    for (int e = 0; e < 4; ++e) { S[kk][e] = a0[kk] * S[kk][e] + k0[kk] * vv[e]; o[e] += q0[kk] * S[kk][e]; }
#pragma unroll
                for (int kk = 0; kk < 4; ++kk)
#pragma unroll
                    for (int e = 0; e < 4; ++e) { S[4 + kk][e] = a1[kk] * S[4 + kk][e] + k1[kk] * vv[e]; o[e] += q1[kk] * S[4 + kk][e]; }
#pragma unroll
                for (int e = 0; e < 4; ++e) o[e] = sum16(o[e]);
                if (kg == 0) *(LAS f32x4*)(os + i * 128 + vg * 4) = (f32x4){o[0], o[1], o[2], o[3]};
            }
            __syncthreads();
            if (tid < 256) { const int st = tid >> 4, part = tid & 15; const int row = step_row(b, d, c * 16 + st, colmajor);
              const f32x4 v0 = *(const LAS f32x4*)(os + st * 128 + part * 8), v1 = *(const LAS f32x4*)(os + st * 128 + part * 8 + 4);
              u32x4 w; w.x = cvt_pk_bf16(v0[0], v0[1]); w.y = cvt_pk_bf16(v0[2], v0[3]); w.z = cvt_pk_bf16(v1[0], v1[1]); w.w = cvt_pk_bf16(v1[2], v1[3]);
              *(u32x4*)(O + (size_t)row * DM + head * 256 + vh * 128 + part * 8) = w; }
            if (c + 1 < 144) GLA_STORE(buf ^ 1);
            __syncthreads();
        }
#undef GLA_LOAD
#undef GLA_STORE
    }
}


__device__ __forceinline__ void phase_gla_chunk(KP p, int l, LAS unsigned char* lds) {
    unsigned char* const ws = ows(p); const int BID_ = obid(), GRD_ = ogrid();
    const int colmajor = l & 1;
    LAS bf16_t* Qin = (LAS bf16_t*)lds;
    LAS bf16_t* Kin = Qin + 8704;
    LAS bf16_t* KstT = Kin + 8704;
    LAS bf16_t* VT = KstT + 9216;
    LAS bf16_t* LAr = VT + 9216;
    LAS bf16_t* Att = LAr;
    LAS float* als = (LAS float*)(LAr + 4608);
    LAS bf16_t* STs = LAr + 8704;
    LAS float* tot = (LAS float*)(lds + 123904);
    LAS float* blast = tot + 512;
    const int tid = otid(), wid = tid >> 6, lane = tid & 63, r16 = lane & 15, quad = lane >> 4, kch = tid & 127, seg = tid >> 7;
    const bf16_t* R = (const bf16_t*)(ws + WS_R);
    const float* ALS = (const float*)(ws + WS_ALS);
    for (int unit = BID_; unit < 256; unit += GRD_) {
        const int ux = unit & 7, uy = unit >> 3; const int b = uy >> 1, d = ux >> 2, head = ux & 3, vh = uy & 1;
        bf16_t* O = d ? (bf16_t*)(ws + WS_YB + BRSZ) : (bf16_t*)(ws + WS_BR + 2 * BRSZ);
        for (int i = tid; i < 8704; i += 512) ((LAS unsigned*)STs)[i] = 0u;
        for (int i = tid; i < 2304; i += 512) ((LAS unsigned*)Att)[i] = 0u;
        f32x4 ST[8];
#pragma unroll
        for (int i = 0; i < 8; ++i) ST[i] = (f32x4){0.f, 0.f, 0.f, 0.f};
        u32x4 ldv[6]; f32x4 lda = (f32x4){0.f, 0.f, 0.f, 0.f};
        float wg[16];
#pragma unroll
        for (int r = 0; r < 16; ++r) wg[r] = p->in[24][((size_t)((l * 2 + d) * 16 + r)) * 512 + head * 128 + kch];
        const float bgk = p->in[25][(size_t)(l * 2 + d) * 512 + head * 128 + kch];
#define GC_LOAD(chunk) do { const int row = step_row(b, d, (chunk) * 64 + lane, colmajor); const bf16_t* rp = R + (size_t)row * 3328; \
            ldv[0] = *(const u32x4*)(rp + head * 128 + wid * 8); ldv[1] = *(const u32x4*)(rp + head * 128 + 64 + wid * 8); \
            ldv[2] = *(const u32x4*)(rp + 512 + head * 128 + wid * 8); ldv[3] = *(const u32x4*)(rp + 512 + head * 128 + 64 + wid * 8); \
            ldv[4] = *(const u32x4*)(rp + 1024 + head * 256 + vh * 128 + wid * 8); ldv[5] = *(const u32x4*)(rp + 1024 + head * 256 + vh * 128 + 64 + wid * 8); \
            if (tid < 256) { const int rowa = step_row(b, d, (chunk) * 64 + (tid >> 2), colmajor); lda = *(const f32x4*)(ALS + (size_t)rowa * 32 + d * 16 + (tid & 3) * 4); } } while (0)
#define GC_STORE() do { \
            _Pragma("unroll") for (int j = 0; j < 2; ++j) { const int c0 = (wid + 8 * j) * 8; \
                *(LAS u32x4*)(Qin + lane * 136 + c0) = ldv[j]; *(LAS u32x4*)(Kin + lane * 136 + c0) = ldv[2 + j]; \
                const unsigned wv[4] = {ldv[4 + j].x, ldv[4 + j].y, ldv[4 + j].z, ldv[4 + j].w}; \
                _Pragma("unroll") for (int e = 0; e < 8; ++e) VT[(c0 + e) * 72 + lane] = (bf16_t)((e & 1) ? (wv[e >> 1] >> 16) : (wv[e >> 1] & 0xffffu)); } \
            if (tid < 256) *(LAS f32x4*)(als + (tid >> 2) * 16 + (tid & 3) * 4) = lda; } while (0)
        GC_LOAD(0); GC_STORE();
        __syncthreads();
        for (int c = 0; c < 36; ++c) {
            if (c + 1 < 36) GC_LOAD(c + 1);
            { float lav[16]; float run = 0.f;
#pragma unroll
              for (int i = 0; i < 16; ++i) { const LAS float* ap = als + (seg * 16 + i) * 16;
                  const f32x4 a0 = *(const LAS f32x4*)ap, a1 = *(const LAS f32x4*)(ap + 4), a2 = *(const LAS f32x4*)(ap + 8), a3 = *(const LAS f32x4*)(ap + 12);
                  float z = bgk;
#pragma unroll
                  for (int r = 0; r < 4; ++r) z += a0[r] * wg[r] + a1[r] * wg[4 + r] + a2[r] * wg[8 + r] + a3[r] * wg[12 + r];
                  run += (fminf(z, 0.f) - __logf(1.f + __expf(-fabsf(z)))) * (1.f / 16.f); lav[i] = run; }
              tot[seg * 128 + kch] = run;
              __syncthreads();
              float off = 0.f, bl = 0.f;
#pragma unroll
              for (int s2 = 0; s2 < 4; ++s2) { const float t_ = tot[s2 * 128 + kch]; bl += t_; if (s2 < seg) off += t_; }
              if (seg == 0) blast[kch] = bl;
              float kst[16];
              const float ebl = __expf(bl);
#pragma unroll
              for (int i = 0; i < 16; ++i) { const int o_ = (seg * 16 + i) * 136 + kch; kst[i] = bf2f(Kin[o_]); lav[i] = off + lav[i]; }
              float qraw[16];
#pragma unroll
              for (int i = 0; i < 16; ++i) qraw[i] = bf2f(Qin[(seg * 16 + i) * 136 + kch]);
#pragma unroll
              for (int i = 0; i < 16; ++i) { const float e1 = __expf(lav[i]), e2 = __builtin_amdgcn_rcpf(e1);
                  qraw[i] *= 0.08838834764831845f * e1; kst[i] *= e2; }
#pragma unroll
              for (int i = 0; i < 16; ++i) { const int o_ = (seg * 16 + i) * 136 + kch; Qin[o_] = f2bf(qraw[i]); Kin[o_] = f2bf(kst[i]); kst[i] *= ebl; }
              { float f0[8], f1[8];
#pragma unroll
                for (int e = 0; e < 8; ++e) { f0[e] = kst[e]; f1[e] = kst[8 + e]; }
                *(LAS u32x4*)(KstT + kch * 72 + seg * 16) = pack8(f0); *(LAS u32x4*)(KstT + kch * 72 + seg * 16 + 8) = pack8(f1); } }
            __syncthreads();
            { const int lt = wid >> 1;
#pragma unroll
              for (int t2 = 0; t2 < 2; ++t2) { const int st = (wid & 1) * 2 + t2;
                  if (st <= lt) {
                      f32x4 acc = (f32x4){0.f, 0.f, 0.f, 0.f};
                      acc = mma16(Kin, 136, st * 16, Qin, 136, lt * 16, 4, acc, lane);
                      const int l_ = lt * 16 + r16, s0_ = st * 16 + quad * 4;
                      u32x2 w; w.x = cvt_pk_bf16((s0_ <= l_) ? acc[0] : 0.f, (s0_ + 1 <= l_) ? acc[1] : 0.f); w.y = cvt_pk_bf16((s0_ + 2 <= l_) ? acc[2] : 0.f, (s0_ + 3 <= l_) ? acc[3] : 0.f);
                      *(LAS u32x2*)(Att + l_ * 72 + s0_) = w; } } }
            __syncthreads();
            { const int lt = wid & 3, vt0 = (wid >> 2) * 4;
              bf16x8 bq[4], ba_[2];
#pragma unroll
              for (int kk = 0; kk < 4; ++kk) bq[kk] = *(const LAS bf16x8*)(Qin + (lt * 16 + r16) * 136 + kk * 32 + quad * 8);
#pragma unroll
              for (int kk = 0; kk < 2; ++kk) ba_[kk] = *(const LAS bf16x8*)(Att + (lt * 16 + r16) * 72 + kk * 32 + quad * 8);
              const int row = step_row(b, d, c * 64 + lt * 16 + r16, colmajor);
              bf16_t* op = O + (size_t)row * DM + head * 256 + vh * 128 + vt0 * 16 + quad * 4;
#pragma unroll
              for (int i = 0; i < 4; ++i) { f32x4 a = (f32x4){0.f, 0.f, 0.f, 0.f};
#pragma unroll
                  for (int kk = 0; kk < 2; ++kk) a = __builtin_amdgcn_mfma_f32_16x16x32_bf16(*(const LAS bf16x8*)(VT + ((vt0 + i) * 16 + r16) * 72 + kk * 32 + quad * 8), ba_[kk], a, 0, 0, 0);
#pragma unroll
                  for (int kk = 0; kk < 4; ++kk) a = __builtin_amdgcn_mfma_f32_16x16x32_bf16(*(const LAS bf16x8*)(STs + ((vt0 + i) * 16 + r16) * 136 + kk * 32 + quad * 8), bq[kk], a, 0, 0, 0);
                  u32x2 w; w.x = cvt_pk_bf16(a[0], a[1]); w.y = cvt_pk_bf16(a[2], a[3]);
                  *(u32x2*)(op + i * 16) = w; } }
            __syncthreads();
            {
#pragma unroll
              for (int kt = 0; kt < 8; ++kt) ST[kt] = ST[kt] * __expf(blast[kt * 16 + r16]);
              bf16x8 av_[2];
#pragma unroll
              for (int kk = 0; kk < 2; ++kk) av_[kk] = *(const LAS bf16x8*)(VT + (wid * 16 + r16) * 72 + kk * 32 + quad * 8);
#pragma unroll
              for (int kt = 0; kt < 8; ++kt) {
#pragma unroll
                  for (int kk = 0; kk < 2; ++kk) ST[kt] = __builtin_amdgcn_mfma_f32_16x16x32_bf16(av_[kk], *(const LAS bf16x8*)(KstT + (kt * 16 + r16) * 72 + kk * 32 + quad * 8), ST[kt], 0, 0, 0); }
#pragma unroll
              for (int kt = 0; kt < 8; ++kt)
#pragma unroll
                  for (int j = 0; j < 4; ++j) STs[(wid * 16 + quad * 4 + j) * 136 + kt * 16 + r16] = f2bf(ST[kt][j]); }
            __syncthreads();
            if (c + 1 < 36) GC_STORE();
            __syncthreads();
        }
#undef GC_LOAD
#undef GC_STORE
    }
}

__device__ __forceinline__ void phase_gla_combine(KP p, int l) {
    unsigned char* const ws = ows(p); const int BID_ = obid(), GRD_ = ogrid(); (void)ws; (void)BID_; (void)GRD_;
    const int tid_ = otid(); const int gw = BID_ * 8 + (tid_ >> 6), GW = GRD_ * 8, lane = tid_ & 63;
    const bf16_t* R = (const bf16_t*)(ws + WS_R);
    bf16_t* BR2 = (bf16_t*)(ws + WS_BR + 2 * BRSZ); const bf16_t* OB = (const bf16_t*)(ws + WS_YB + BRSZ);
    const f32x4 ng = *(const f32x4*)(p->in[26] + (size_t)l * 256 + lane * 4);
    for (int rp = gw; rp < TT / 2; rp += GW) {
        f32x4 o[2][4]; u32x2 gz[2][4];
#pragma unroll
        for (int r = 0; r < 2; ++r) { const int row = rp * 2 + r;
#pragma unroll
            for (int j = 0; j < 4; ++j) { const int col = j * 256 + lane * 4;
                const u32x2 f = *(const u32x2*)(BR2 + (size_t)row * DM + col), bk = *(const u32x2*)(OB + (size_t)row * DM + col);
                gz[r][j] = *(const u32x2*)(R + (size_t)row * 3328 + 2048 + col);
                o[r][j] = (f32x4){bflo(f.x) + bflo(bk.x), bfhi(f.x) + bfhi(bk.x), bflo(f.y) + bflo(bk.y), bfhi(f.y) + bfhi(bk.y)}; } }
        float qq[2][4];
#pragma unroll
        for (int r = 0; r < 2; ++r)
#pragma unroll
            for (int j = 0; j < 4; ++j) qq[r][j] = wave_sum(o[r][j][0] * o[r][j][0] + o[r][j][1] * o[r][j][1] + o[r][j][2] * o[r][j][2] + o[r][j][3] * o[r][j][3], lane);
#pragma unroll
        for (int r = 0; r < 2; ++r) { const int row = rp * 2 + r;
#pragma unroll
            for (int j = 0; j < 4; ++j) { const int col = j * 256 + lane * 4;
                const float rstd = rsqrtf(qq[r][j] * (1.f / 256.f) + EPS);
                u32x2 w; w.x = cvt_pk_bf16(o[r][j][0] * rstd * ng[0] * silu(bflo(gz[r][j].x)), o[r][j][1] * rstd * ng[1] * silu(bfhi(gz[r][j].x)));
                w.y = cvt_pk_bf16(o[r][j][2] * rstd * ng[2] * silu(bflo(gz[r][j].y)), o[r][j][3] * rstd * ng[3] * silu(bfhi(gz[r][j].y)));
                *(u32x2*)(BR2 + (size_t)row * DM + col) = w; } }
    }
}
#define p kparams()
#define G ogrid()
#define bid obid()
#define U ((bf16_t*)(ows(p) + WS_U))
#define R ((bf16_t*)(ows(p) + WS_R))
#define YB ((float*)(ows(p) + WS_YB))
#define BR ((bf16_t*)(ows(p) + WS_BR))
#define WUP ((const bf16_t*)(ows(p) + WS_WUP))
#define WDN ((const bf16_t*)(ows(p) + WS_WDN))
#define WIN ((const bf16_t*)(ows(p) + WS_WIN))
#define WBR ((const bf16_t*)(ows(p) + WS_WBR))
#define WOUT ((const bf16_t*)(ows(p) + WS_WOUT))
#define WLRU ((const bf16_t*)(ows(p) + WS_WLRU))
#define xst ((volatile LAS unsigned*)((LAS unsigned char*)shm + 131072))
#define GSYNC() xcd_barrier((unsigned*)(ows(p) + WS_BAR), xst)
#undef xst
#define xst ((volatile LAS unsigned*)(lds + 131072))
#ifndef REP_GEMM
#define REP_GEMM 1
#endif
#ifndef REP_SCAN
#define REP_SCAN 1
#endif
#ifndef REP_LIGHT
#define REP_LIGHT 1
#endif
__device__ __forceinline__ void layer_half(const int l, const int f, LAS unsigned char* lds) {
    pg8::StaticOrder S;
    const int MR = (l == DEPTH - 1) ? TL : TT;
            if (f == 1) {
                { pg8::Gemm g{U, WIN, TT, 3328, 1024, 1024, 1024, 0}; S.init(TT, 3328, G, bid);
                  pg8::EpiBf16Side E{R, 3328, (float*)(ows(p) + WS_DTS), 3072}; for (int rep_ = 0; rep_ < REP_GEMM; ++rep_) pg8::gemm_phase(lds, g, S, E); }
                GSYNC();
                for (int rep_ = 0; rep_ < REP_LIGHT; ++rep_) phase_ssd_conv(p, l);
                GSYNC();
                for (int rep_ = 0; rep_ < REP_SCAN; ++rep_) phase_ssd_chunk(p, l, lds);
                GSYNC();
                for (int rep_ = 0; rep_ < REP_LIGHT; ++rep_) phase_ssd_combine(p, l);
                { pg8::Gemm g{U, WIN + (size_t)3104 * 1024, TT, 2048, 1024, 1024, 1024, 0}; S.init(TT, 2048, G, bid);
                  pg8::EpiBf16Side E{(bf16_t*)YB, 2048, nullptr, -1}; for (int rep_ = 0; rep_ < REP_GEMM; ++rep_) pg8::gemm_phase(lds, g, S, E); }
                GSYNC();
                phase_lru_fused(p, l, lds);
                __syncthreads();
                { pg8::Gemm g{U, WIN + (size_t)5152 * 1024, TT, 3328, 1024, 1024, 1024, 0}; S.init(TT, 3328, G, bid);
                  pg8::EpiBf16Side E{R, 3328, (float*)(ows(p) + WS_ALS), 3072}; for (int rep_ = 0; rep_ < REP_GEMM; ++rep_) pg8::gemm_phase(lds, g, S, E); }
                GSYNC();
                for (int rep_ = 0; rep_ < REP_SCAN; ++rep_) phase_gla_chunk(p, l, lds);
                GSYNC();
                phase_gla_combine(p, l);
                GSYNC();
                { pg8::Gemm g{U, WIN + (size_t)8256 * 1024, MR, 3072, 1024, 1024, 1024, 0}; S.init(MR, 3072, G, bid);
                  pg8::EpiBf16Side E{R, 3072, nullptr, -1}; for (int rep_ = 0; rep_ < REP_GEMM; ++rep_) pg8::gemm_phase(lds, g, S, E); }
                GSYNC();
                S.init(MR, 1024, G, bid);
                { pg8::Gemm g{BR, WBR, MR, 1024, 1024, 1024, 1024, 0}; pg8::EpiMerge<0> E{R, (bf16_t*)YB, U}; pg8::gemm_phase(lds, g, S, E); }
                { pg8::Gemm g{BR + (size_t)TT * DM, WBR + (size_t)1024 * 1024, MR, 1024, 1024, 1024, 1024, 0}; pg8::EpiMerge<1> E{R, (bf16_t*)YB, U}; pg8::gemm_phase(lds, g, S, E); }
                { pg8::Gemm g{BR + 2 * (size_t)TT * DM, WBR + (size_t)2 * 1024 * 1024, MR, 1024, 1024, 1024, 1024, 0}; pg8::EpiMerge<2> E{R, (bf16_t*)YB, U}; pg8::gemm_phase(lds, g, S, E); }
                GSYNC();
                { pg8::Gemm g{U, WOUT, MR, 1024, 1024, 1024, 1024, 0}; S.init(MR, 1024, G, bid);
                  pg8::EpiBf16Side E{(bf16_t*)YB, 1024, nullptr, -1}; for (int rep_ = 0; rep_ < REP_GEMM; ++rep_) pg8::gemm_phase(lds, g, S, E); }
                GSYNC();
                phase_ln(p, l, 5, 1.0f, 1, l, 6, MR);
                GSYNC();
            }
            { const int MF = f ? MR : TT; pg8::Gemm g{U, WUP + (size_t)f * 5632 * 1024, MF, 5632, 1024, 1024, 1024, 0}; S.init(MF, 5632, G, bid);
              pg8::EpiSwiglu E{R}; for (int rep_ = 0; rep_ < REP_GEMM; ++rep_) pg8::gemm_phase(lds, g, S, E); }
            GSYNC();
            { const int MF = f ? MR : TT; pg8::Gemm g{R, WDN + (size_t)f * 1024 * 2816, MF, 1024, 2816, 2816, 2816, 0}; S.init(MF, 1024, G, bid);
              pg8::EpiBf16Side E{(bf16_t*)YB, 1024, nullptr, -1}; for (int rep_ = 0; rep_ < REP_GEMM; ++rep_) pg8::gemm_phase(lds, g, S, E); }
            GSYNC();
            if (f == 0) phase_ln(p, l, 2, 0.5f, 0, l, 3, TT);
            else { phase_ln(p, l, 8, 0.5f, 2, l + 1 < DEPTH ? l + 1 : -1, 0, MR); if (l + 1 < DEPTH) for (int rep_ = 0; rep_ < REP_LIGHT; ++rep_) phase_convert(p, l + 1, lds); }
            GSYNC();
}
__global__ void __launch_bounds__(512, 2) mega(Params p_arg) {
    extern __shared__ __attribute__((aligned(16))) unsigned char shm[];
    LAS unsigned char* lds = (LAS unsigned char*)shm;
    cg::grid_group grid = cg::this_grid();
    pg8::StaticOrder S;
    if (threadIdx.x == 0) { xst[0] = 0u; xst[1] = 0u; }
    __syncthreads();
    if (threadIdx.x == 0) (void)xb_add(&((unsigned*)(p->ws + WS_BAR))[XB_XCNT(xb_xcc_id())], 1u);

    phase_mods(p, lds);
    phase_convert(p, 0, lds);
    if (p->ws == nullptr) grid.sync();
    GSYNC();
    phase_init(p);
    GSYNC();

    layer_half(0, 0, lds); layer_half(0, 1, lds);
    layer_half(1, 0, lds); layer_half(1, 1, lds);
    layer_half(2, 0, lds); layer_half(2, 1, lds);
    layer_half(3, 0, lds); layer_half(3, 1, lds);
}

#undef GSYNC
#undef xst
#undef p
#undef G
#undef bid
#undef U
#undef R
#undef YB
#undef BR
#undef WUP
#undef WDN
#undef WIN
#undef WBR
#undef WOUT
#undef WLRU
extern "C" void kernel_launch(void* const* d_in, const int* in_sizes, int n_in, void* d_out, int out_size, void* d_ws, size_t ws_size, hipStream_t stream) {
    constexpr int LDS_BYTES = pg8::STAGE_BYTES + 16;
    static int grid = 0;
    if (grid == 0) {
        if (n_in != 29 || ws_size < WS_END) { fprintf(stderr, "kernel_launch: unexpected n_in %d / ws_size %zu (need %zu)\n", n_in, ws_size, (size_t)WS_END); grid = -1; return; }
        int dev = 0, cus = 0, per_cu = 0;
        hipGetDevice(&dev);
        hipDeviceGetAttribute(&cus, hipDeviceAttributeMultiprocessorCount, dev);
        if (hipFuncSetAttribute((const void*)mega, hipFuncAttributeMaxDynamicSharedMemorySize, LDS_BYTES) != hipSuccess) { fprintf(stderr, "kernel_launch: hipFuncSetAttribute failed\n"); grid = -1; return; }
        if (hipOccupancyMaxActiveBlocksPerMultiprocessor(&per_cu, (const void*)mega, 512, LDS_BYTES) != hipSuccess || per_cu < 1) { fprintf(stderr, "kernel_launch: occupancy query failed (%d)\n", per_cu); per_cu = 1; }
        (void)hipGetLastError();
        grid = cus * 1;
        fprintf(stderr, "kernel_launch: grid %d (cus %d, per_cu %d)\n", grid, cus, per_cu);
    }
    if (grid < 0) return;
    if (hipMemsetAsync((unsigned char*)d_ws + WS_BAR, 0, (size_t)XCD_BAR_WORDS_C * 4, stream) != hipSuccess) { fprintf(stderr, "kernel_launch: barrier memset failed\n"); return; }
    Params p{};
    for (int i = 0; i < 29; ++i) p.in[i] = (const float*)d_in[i];
    p.out = (float*)d_out; p.ws = (unsigned char*)d_ws;
    void* args[] = {&p};
    hipError_t e = hipLaunchCooperativeKernel((const void*)mega, dim3(grid), dim3(512), args, LDS_BYTES, stream);
    if (e != hipSuccess) fprintf(stderr, "kernel_launch: cooperative launch failed: %s (grid %d)\n", hipGetErrorString(e), grid);
}
```

```cpp
#include <hip/hip_runtime.h>
#include <hip/hip_cooperative_groups.h>
#include <cstdio>
namespace cg = cooperative_groups;

#define LAS __attribute__((address_space(3)))
typedef unsigned short bf16_t;
typedef short bf16x8 __attribute__((ext_vector_type(8)));
typedef float f32x4 __attribute__((ext_vector_type(4)));
typedef float f32x2 __attribute__((ext_vector_type(2)));
typedef unsigned u32x4 __attribute__((ext_vector_type(4)));
typedef unsigned u32x2 __attribute__((ext_vector_type(2)));

constexpr int DM = 1024, NBATCH = 16, SEQ = 2048, CTXL = 256, DEPTH = 4;
constexpr int TL = NBATCH * SEQ, TC = NBATCH * CTXL, TT = TL + TC;
constexpr int DFF = 2816, INTOT = 11328;
constexpr float ALPHA = 1.681792830507429f;
constexpr float EPS = 1e-5f;
constexpr int XCD_BAR_WORDS_C = 3456;

constexpr size_t WS_HCTX = 0;
constexpr size_t WS_MODS = WS_HCTX + (size_t)TC * DM * 4;
constexpr size_t WS_U    = WS_MODS + (size_t)DEPTH * 17 * 9216 * 4;
constexpr size_t WS_R    = WS_U + (size_t)TT * DM * 2;
constexpr size_t WS_YB   = WS_R + (size_t)TT * 3328 * 2;
constexpr size_t WS_BR   = WS_YB + (size_t)TT * DM * 4;
constexpr size_t BRSZ    = (size_t)TT * DM * 2;
constexpr size_t WS_WUP  = WS_BR + 3 * BRSZ;
constexpr size_t WS_WDN  = WS_WUP + (size_t)2 * 5632 * 1024 * 2;
constexpr size_t WS_WIN  = WS_WDN + (size_t)2 * 1024 * 2816 * 2;
constexpr size_t WS_WBR  = WS_WIN + (size_t)(INTOT + 256) * 1024 * 2;
constexpr size_t WS_WOUT = WS_WBR + (size_t)3 * 1024 * 1024 * 2;
constexpr size_t WS_WLRU = WS_WOUT + (size_t)1024 * 1024 * 2;
constexpr size_t WS_DTS  = WS_WLRU + (size_t)2 * 4096 * 256 * 2;
constexpr size_t WS_ALS  = WS_DTS + (size_t)TT * 32 * 4;
constexpr size_t WS_DTA  = WS_ALS + (size_t)TT * 32 * 4;
constexpr size_t WS_BAR  = WS_DTA + (size_t)TT * 32 * 2 * 4;
constexpr size_t WS_END  = WS_BAR + (size_t)XCD_BAR_WORDS_C * 4;

struct Params { const float* in[29]; float* out; unsigned char* ws; };
typedef const Params __attribute__((address_space(4)))* KP;
__device__ __forceinline__ KP kparams() { KP k = (KP)__builtin_amdgcn_kernarg_segment_ptr(); asm volatile("" : "+s"(k)); return k; }

typedef __bf16 bf16x2_t __attribute__((ext_vector_type(2)));
__device__ __forceinline__ unsigned cvt_pk_bf16(float lo, float hi) { bf16x2_t v; v.x = (__bf16)lo; v.y = (__bf16)hi; return __builtin_bit_cast(unsigned, v); }
__device__ __forceinline__ bf16_t f2bf(float f) { return __builtin_bit_cast(unsigned short, (__bf16)f); }
__device__ __forceinline__ float bflo(unsigned w) { return __uint_as_float(w << 16); }
__device__ __forceinline__ float bfhi(unsigned w) { return __uint_as_float(w & 0xffff0000u); }
__device__ __forceinline__ float bf2f(bf16_t b) { return __uint_as_float(((unsigned)b) << 16); }
__device__ __forceinline__ float sigm(float x) { return __builtin_amdgcn_rcpf(1.f + __expf(-x)); }
__device__ __forceinline__ float silu(float x) { return x * __builtin_amdgcn_rcpf(1.f + __expf(-x)); }
__device__ __forceinline__ float softplus(float x) { return fmaxf(x, 0.f) + log1pf(__expf(-fabsf(x))); }
__device__ __forceinline__ float gelu_tanh(float x) { const float u = 0.7978845608028654f * (x + 0.044715f * x * x * x); return x * (1.f - __builtin_amdgcn_rcpf(1.f + __expf(2.f * u))); }
__device__ __forceinline__ void unpack8(u32x4 w, float (&f)[8]) { f[0] = bflo(w.x); f[1] = bfhi(w.x); f[2] = bflo(w.y); f[3] = bfhi(w.y); f[4] = bflo(w.z); f[5] = bfhi(w.z); f[6] = bflo(w.w); f[7] = bfhi(w.w); }
__device__ __forceinline__ u32x4 pack8(const float (&f)[8]) { u32x4 w; w.x = cvt_pk_bf16(f[0], f[1]); w.y = cvt_pk_bf16(f[2], f[3]); w.z = cvt_pk_bf16(f[4], f[5]); w.w = cvt_pk_bf16(f[6], f[7]); return w; }
__device__ __forceinline__ float dppf(float v, const int ctrl_sel) {
    int r;
    if (ctrl_sel == 0) r = __builtin_amdgcn_update_dpp(0, __float_as_int(v), 0xB1, 0xF, 0xF, true);
    else if (ctrl_sel == 1) r = __builtin_amdgcn_update_dpp(0, __float_as_int(v), 0x4E, 0xF, 0xF, true);
    else if (ctrl_sel == 2) r = __builtin_amdgcn_update_dpp(0, __float_as_int(v), 0x141, 0xF, 0xF, true);
    else r = __builtin_amdgcn_update_dpp(0, __float_as_int(v), 0x140, 0xF, 0xF, true);
    return __int_as_float(r);
}
__device__ __forceinline__ float sum16(float v) { v += dppf(v, 0); v += dppf(v, 1); v += dppf(v, 2); v += dppf(v, 3); return v; }
__device__ __forceinline__ float wave_sum(float v, int lane) {
    v = sum16(v);
    v += __int_as_float(__builtin_amdgcn_ds_bpermute((lane ^ 16) << 2, __float_as_int(v)));
    v += __int_as_float(__builtin_amdgcn_ds_bpermute((lane ^ 32) << 2, __float_as_int(v)));
    return v;
}

__device__ __forceinline__ int obid() { int t = (int)blockIdx.x; asm volatile("" : "+s"(t)); return t; }
__device__ __forceinline__ int ogrid() { int t = (int)gridDim.x; asm volatile("" : "+s"(t)); return t; }
__device__ __forceinline__ int otid() { int t = (int)threadIdx.x; asm volatile("" : "+v"(t)); return t; }
__device__ __forceinline__ unsigned char* ows(KP p) { unsigned char* w = p->ws; asm volatile("" : "+s"(w)); return w; }
__device__ __forceinline__ int step_row(int b, int d, int s, int colmajor) {
    if (s < CTXL) { const int t = d ? (CTXL - 1 - s) : s; return TL + b * CTXL + t; }
    int q = s - CTXL; if (d) q = SEQ - 1 - q;
    const int tok = colmajor ? ((q & 31) * 64 + (q >> 5)) : q;
    return b * SEQ + tok;
}
__device__ __forceinline__ float* hrow(KP p, int row) { return row < TL ? p->out + (size_t)row * DM : (float*)(p->ws + WS_HCTX) + (size_t)(row - TL) * DM; }
__device__ __forceinline__ const float* modp(KP p, int l, int row, int idx) { const int r = row < TL ? (row >> 11) : 16; return (const float*)(p->ws + WS_MODS) + ((size_t)(l * 17 + r) * 9 + idx) * DM; }


#define XB_TMO      128
#define XB_XCNT(j)  (256  + 64 * (j))
#define XB_XSUB(j)  (1280 + 64 * (j))
#define XB_XGEN(j)  (2304 + 64 * (j))
#define XB_TOP      3328
#define XB_TOPGEN   3392
#define XB_SPIN_CAP (1u << 22)
__device__ __forceinline__ unsigned xb_ld(unsigned* q)              { return __hip_atomic_load(q, __ATOMIC_RELAXED, __HIP_MEMORY_SCOPE_AGENT); }
__device__ __forceinline__ unsigned xb_add(unsigned* q, unsigned v) { return __hip_atomic_fetch_add(q, v, __ATOMIC_RELAXED, __HIP_MEMORY_SCOPE_AGENT); }
__device__ __forceinline__ unsigned xb_xcc_id() { return (unsigned)__builtin_amdgcn_s_getreg((3 << 11) | 20) & 0xFu; }
#define XB_SPIN(cond, bar) do { unsigned _sp = 0; while (cond) { __builtin_amdgcn_s_sleep(1); \
    if ((++_sp & 255u) == 0u) { if (xb_ld(&(bar)[XB_TMO])) break; if (_sp > XB_SPIN_CAP) { atomicAdd(&(bar)[XB_TMO], 1u); break; } } } } while (0)
__device__ __forceinline__ void xcd_barrier_complete(unsigned* bar, unsigned x, unsigned& nloc, unsigned& nx) {
    const unsigned G = gridDim.x * gridDim.y * gridDim.z;
    unsigned sum, cnt, mine, sp = 0u;
    for (;;) {
        sum = 0u; cnt = 0u; mine = 0u;
#pragma unroll
        for (unsigned j = 0; j < 16; ++j) { const unsigned c = xb_ld(&bar[XB_XCNT(j)]); sum += c; cnt += (c > 0u) ? 1u : 0u; mine = (j == x) ? c : mine; }
        if (sum == G) break;
        __builtin_amdgcn_s_sleep(1);
        if ((++sp & 255u) == 0u) { if (xb_ld(&bar[XB_TMO])) break; if (sp > XB_SPIN_CAP) { atomicAdd(&bar[XB_TMO], 1u); break; } }
    }
    nloc = mine > 0u ? mine : 1u; nx = cnt > 0u ? cnt : 1u;
}
__device__ __forceinline__ void xcd_barrier(unsigned* bar, volatile LAS unsigned* st) {
    asm volatile("s_waitcnt vmcnt(0)" ::: "memory");
    __syncthreads();
    if (threadIdx.x == 0) {
        const unsigned x = xb_xcc_id();
        __builtin_amdgcn_s_waitcnt(0);
        unsigned nloc = st[0], nx = st[1];
        if (nloc == 0u) { xcd_barrier_complete(bar, x, nloc, nx); st[0] = nloc; st[1] = nx; }
        const unsigned old = xb_add(&bar[XB_XSUB(x)], 1u);
        const unsigned gen = old / nloc;
        if (old + 1u == (gen + 1u) * nloc) {
            __builtin_amdgcn_fence(__ATOMIC_RELEASE, "agent");
            asm volatile("s_waitcnt vmcnt(0)" ::: "memory");
            const unsigned og = xb_add(&bar[XB_TOP], 1u);
            const unsigned tg = og / nx;
            if (og + 1u == (tg + 1u) * nx) xb_add(&bar[XB_TOPGEN], 1u);
            else XB_SPIN(xb_ld(&bar[XB_TOPGEN]) == tg, bar);
            __builtin_amdgcn_fence(__ATOMIC_ACQUIRE, "agent");
            xb_add(&bar[XB_XGEN(x)], 1u);
            asm volatile("s_waitcnt vmcnt(0)" ::: "memory");
        } else {
            XB_SPIN(xb_ld(&bar[XB_XGEN(x)]) == gen, bar);
            __builtin_amdgcn_fence(__ATOMIC_ACQUIRE, "agent");
            asm volatile("s_waitcnt vmcnt(0)" ::: "memory");
        }
    }
    __syncthreads();
}

namespace pg8 {
constexpr int BM = 256, BK = 64, HALF = 128, HTB = HALF * BK * 2, STAGE_BYTES = 8 * HTB, NXCD = 8, WGM = 4;
__device__ __forceinline__ int lds_byte(int r, int c) { const int st = (r >> 4) * 2 + (c >> 5), rr = r & 15, cc = c & 31, ob = rr * 64 + cc * 2; return st * 1024 + (ob ^ (((ob >> 9) & 1) << 5)); }
__device__ __forceinline__ void stage_rc(int b, int& R, int& C) { const int st = b / 1024, sb = b % 1024, swz = sb ^ (((sb >> 9) & 1) << 5); R = (st >> 1) * 16 + swz / 64; C = (st & 1) * 32 + (swz % 64) / 2; }
__device__ __forceinline__ int perm32(int rho) { const int n = rho >> 4, i = rho & 15; return 8 * (i >> 2) + 4 * n + (i & 3); }
struct Unit { int pm, pn; };
struct Gemm { const bf16_t* A; const bf16_t* Bt; int M, N, K, lda, ldb, akoff; };
struct StaticOrder {
    int nM, nN, nwg, G, c;
    __device__ __forceinline__ void init(int M, int N, int G_, int c_) { nM = M / BM; nN = N / BM; nwg = nM * nN; G = G_; c = c_; }
    __device__ __forceinline__ bool next(int i, Unit& u) const {
        const long L = (long)i * G + c; if (L >= nwg) return false;
        int wgid = (int)L; { const int q = nwg / NXCD, r = nwg % NXCD, xcd = wgid % NXCD, off = wgid / NXCD; wgid = (xcd < r ? xcd * (q + 1) : r * (q + 1) + (xcd - r) * q) + off; }
        const int nig = WGM * nN, gid = wgid / nig, fm = gid * WGM, gsz = (nM - fm) < WGM ? (nM - fm) : WGM;
        u.pm = fm + ((wgid % nig) % gsz); u.pn = (wgid % nig) / gsz; return true;
    }
};

template <class Epi>
__device__ __forceinline__ void gemm_phase(LAS unsigned char* lds, const Gemm g, const StaticOrder& S, const Epi& E) {
    const int tid = otid(), wid = __builtin_amdgcn_readfirstlane(tid >> 6), lane = tid & 63, wr = wid >> 2, wc = wid & 3, fr = lane & 15, fq = lane >> 4;
    const int K = g.K, nt = K / BK;
    unsigned voffA[2], voffB[2];
#pragma unroll
    for (int i = 0; i < 2; ++i) { int R, C; stage_rc(tid * 16 + i * 8192, R, C); const int Rb = Epi::PERM ? ((R & ~31) + perm32(R & 31)) : R;
        voffA[i] = (unsigned)(R * g.lda + C) * 2u; voffB[i] = (unsigned)(Rb * g.ldb + C) * 2u; }
    const size_t kstep = (size_t)(BK * 2);
    const size_t hstepA = (size_t)HALF * g.lda * 2, hstepB = (size_t)HALF * g.ldb * 2;
    const size_t tstepA = 2 * hstepA, tstepB = 2 * hstepB;
    const unsigned ldsw = (unsigned)wid * 1024u;
    const int aoff = lds_byte(wr * 64 + fr, fq * 8), boff = lds_byte(wc * 32 + fr, fq * 8);
#define PG8_SA(b, h) (((b) * 2 + (h)) * HTB)
#define PG8_SB(b, h) ((4 + (b) * 2 + (h)) * HTB)
#define PG8_STAGE(bufoff, gbase, voff) do { _Pragma("unroll") for (int _i = 0; _i < 2; ++_i) \
        __builtin_amdgcn_global_load_lds((const unsigned*)((const char*)(gbase) + (voff)[_i]), (LAS unsigned*)(lds + (bufoff) + ldsw + _i * 8192), 16, 0, 0); } while (0)
#define PG8_LDA(dst, b, h) do { _Pragma("unroll") for (int m = 0; m < 4; ++m) _Pragma("unroll") for (int k = 0; k < 2; ++k) dst[m][k] = *(const LAS bf16x8*)(lds + PG8_SA(b, h) + aoff + m * 2048 + k * 1024); } while (0)
#define PG8_LDB(dst, b, h) do { _Pragma("unroll") for (int n = 0; n < 2; ++n) _Pragma("unroll") for (int k = 0; k < 2; ++k) dst[n][k] = *(const LAS bf16x8*)(lds + PG8_SB(b, h) + boff + n * 2048 + k * 1024); } while (0)
#define PG8_MMA(ai, bj, At, Bt) do { __builtin_amdgcn_s_setprio(1); _Pragma("unroll") for (int m = 0; m < 4; ++m) _Pragma("unroll") for (int n = 0; n < 2; ++n) _Pragma("unroll") for (int k = 0; k < 2; ++k) \
        acc[ai][bj][m][n] = __builtin_amdgcn_mfma_f32_16x16x32_bf16(Bt[n][k], At[m][k], acc[ai][bj][m][n], 0, 0, 0); __builtin_amdgcn_s_setprio(0); } while (0)
#define PG8_WAIT_V(n) asm volatile("s_waitcnt vmcnt(" #n ")" ::: "memory")
#define PG8_WAIT_L(n) asm volatile("s_waitcnt lgkmcnt(" #n ")" ::: "memory")
#define PG8_BAR __builtin_amdgcn_s_barrier()
#define PG8_SCHED __builtin_amdgcn_sched_barrier(0)
#define PG8_ABASE(u) ((const char*)g.A + (size_t)(u).pm * tstepA + (g.akoff ? (size_t)((u).pn >> 1) * 512 : (size_t)0))
#define PG8_BBASE(u) ((const char*)g.Bt + (size_t)(u).pn * tstepB)
    Unit cur, nxt; int ui = 0;
    if (!S.next(0, cur)) return;
    f32x4 acc[2][2][4][2];
#pragma unroll
    for (int a = 0; a < 2; ++a)
#pragma unroll
        for (int b = 0; b < 2; ++b)
#pragma unroll
            for (int m = 0; m < 4; ++m)
#pragma unroll
                for (int n = 0; n < 2; ++n) acc[a][b][m][n] = (f32x4){0.f, 0.f, 0.f, 0.f};
    bf16x8 At[4][2], B0[2][2], B1[2][2];
    const char* cA = PG8_ABASE(cur); const char* cB = PG8_BBASE(cur);
    PG8_STAGE(PG8_SB(0, 0), cB, voffB); PG8_STAGE(PG8_SA(0, 0), cA, voffA); PG8_STAGE(PG8_SB(0, 1), cB + hstepB, voffB); PG8_STAGE(PG8_SA(0, 1), cA + hstepA, voffA);
    if (wr == 1) PG8_BAR;
    PG8_WAIT_V(4); PG8_BAR;
    PG8_STAGE(PG8_SB(1, 0), cB + kstep, voffB); PG8_STAGE(PG8_SA(1, 0), cA + kstep, voffA); PG8_STAGE(PG8_SB(1, 1), cB + hstepB + kstep, voffB);
    PG8_WAIT_V(6); PG8_BAR;
    for (;;) {
        const bool has_next = S.next(ui + 1, nxt);
        const char* nA = has_next ? PG8_ABASE(nxt) : cA; const char* nB = has_next ? PG8_BBASE(nxt) : cB;
        for (int t = 0; t < nt; t += 2) {
            const bool last = (t == nt - 2);
            const char* a1 = cA + (size_t)(t + 1) * kstep;
            const char* a2 = last ? nA : cA + (size_t)(t + 2) * kstep; const char* b2 = last ? nB : cB + (size_t)(t + 2) * kstep;
            const char* a3 = a2 + kstep; const char* b3 = b2 + kstep;
            PG8_LDB(B0, 0, 0); PG8_SCHED; PG8_LDA(At, 0, 0); PG8_STAGE(PG8_SA(1, 1), a1 + hstepA, voffA);
            PG8_WAIT_L(8); PG8_BAR; PG8_WAIT_L(0); PG8_MMA(0, 0, At, B0); PG8_BAR; PG8_SCHED;
            PG8_LDB(B1, 0, 1); PG8_STAGE(PG8_SB(0, 0), b2, voffB);
            PG8_BAR; PG8_WAIT_L(0); PG8_MMA(0, 1, At, B1); PG8_BAR;
            PG8_LDA(At, 0, 1); PG8_STAGE(PG8_SA(0, 0), a2, voffA);
            PG8_BAR; PG8_WAIT_L(0); PG8_MMA(1, 0, At, B0); PG8_BAR; PG8_SCHED;
            PG8_STAGE(PG8_SB(0, 1), b2 + hstepB, voffB);
            PG8_WAIT_V(6); PG8_BAR; PG8_MMA(1, 1, At, B1); PG8_BAR;
            PG8_LDB(B0, 1, 0); PG8_SCHED; PG8_LDA(At, 1, 0); PG8_STAGE(PG8_SA(0, 1), a2 + hstepA, voffA);
            PG8_WAIT_L(8); PG8_BAR; PG8_WAIT_L(0); PG8_MMA(0, 0, At, B0); PG8_BAR; PG8_SCHED;
            PG8_LDB(B1, 1, 1); PG8_STAGE(PG8_SB(1, 0), b3, voffB);
            PG8_BAR; PG8_WAIT_L(0); PG8_MMA(0, 1, At, B1); PG8_BAR;
            PG8_LDA(At, 1, 1); PG8_STAGE(PG8_SA(1, 0), a3, voffA);
            PG8_BAR; PG8_WAIT_L(0); PG8_MMA(1, 0, At, B0); PG8_BAR; PG8_SCHED;
            PG8_STAGE(PG8_SB(1, 1), b3 + hstepB, voffB);
            PG8_WAIT_V(6); PG8_BAR; PG8_MMA(1, 1, At, B1); PG8_BAR;
        }
        E(acc, cur, wr, wc, fr, fq);
        if (!has_next) break;
#pragma unroll
        for (int a = 0; a < 2; ++a)
#pragma unroll
            for (int b = 0; b < 2; ++b)
#pragma unroll
                for (int m = 0; m < 4; ++m)
#pragma unroll
                    for (int n = 0; n < 2; ++n) acc[a][b][m][n] = (f32x4){0.f, 0.f, 0.f, 0.f};
        cur = nxt; cA = nA; cB = nB; ++ui;
    }
    PG8_WAIT_V(0);
    if (wr == 0) PG8_BAR;
    PG8_BAR;
#undef PG8_SA
#undef PG8_SB
#undef PG8_STAGE
#undef PG8_LDA
#undef PG8_LDB
#undef PG8_MMA
#undef PG8_WAIT_V
#undef PG8_WAIT_L
#undef PG8_BAR
#undef PG8_SCHED
#undef PG8_ABASE
#undef PG8_BBASE
}

struct EpiF32 {
    static constexpr bool PERM = false;
    float* C; int ldc;
    __device__ __forceinline__ void operator()(const f32x4 (&acc)[2][2][4][2], const Unit& u, int wr, int wc, int fr, int fq) const {
        const int row0 = u.pm * BM + wr * 64 + fr, col0 = u.pn * BM + wc * 32 + 4 * fq;
#pragma unroll
        for (int ai = 0; ai < 2; ++ai)
#pragma unroll
            for (int m = 0; m < 4; ++m) { float* rowp = C + (size_t)(row0 + ai * HALF + m * 16) * ldc + col0;
#pragma unroll
                for (int bj = 0; bj < 2; ++bj)
#pragma unroll
                    for (int n = 0; n < 2; ++n) *(f32x4*)(rowp + bj * HALF + n * 16) = acc[ai][bj][m][n]; }
    }
};
struct EpiBf16Side {
    static constexpr bool PERM = true;
    bf16_t* O; int ldc; float* side; int side_c0;
    __device__ __forceinline__ void operator()(const f32x4 (&acc)[2][2][4][2], const Unit& u, int wr, int wc, int fr, int fq) const {
        const int row0 = u.pm * BM + wr * 64 + fr, col0 = u.pn * BM + wc * 32 + 8 * fq;
#pragma unroll
        for (int ai = 0; ai < 2; ++ai)
#pragma unroll
            for (int m = 0; m < 4; ++m) { const int row = row0 + ai * HALF + m * 16; bf16_t* rowp = O + (size_t)row * ldc + col0;
#pragma unroll
                for (int bj = 0; bj < 2; ++bj) { const f32x4 v0 = acc[ai][bj][m][0], v1 = acc[ai][bj][m][1];
                    u32x4 w; w.x = cvt_pk_bf16(v0[0], v0[1]); w.y = cvt_pk_bf16(v0[2], v0[3]); w.z = cvt_pk_bf16(v1[0], v1[1]); w.w = cvt_pk_bf16(v1[2], v1[3]);
                    *(u32x4*)(rowp + bj * HALF) = w;
                    if (u.pn * BM + bj * HALF + wc * 32 == side_c0) { float* sp = side + (size_t)row * 32 + 8 * fq; *(f32x4*)sp = v0; *(f32x4*)(sp + 4) = v1; } } }
    }
};
struct EpiSwiglu {
    static constexpr bool PERM = true;
    bf16_t* O;
    __device__ __forceinline__ void operator()(const f32x4 (&acc)[2][2][4][2], const Unit& u, int wr, int wc, int fr, int fq) const {
        const int row0 = u.pm * BM + wr * 64 + fr, col0 = u.pn * HALF + wc * 32 + 8 * fq;
#pragma unroll
        for (int ai = 0; ai < 2; ++ai)
#pragma unroll
            for (int m = 0; m < 4; ++m) { const int row = row0 + ai * HALF + m * 16;
                float r[8];
#pragma unroll
                for (int n = 0; n < 2; ++n)
#pragma unroll
                    for (int j = 0; j < 4; ++j) r[n * 4 + j] = silu(acc[ai][0][m][n][j]) * acc[ai][1][m][n][j];
                *(u32x4*)(O + (size_t)row * DFF + col0) = pack8(r); }
    }
};
template <int NBR> struct EpiMerge {
    static constexpr bool PERM = true;
    const bf16_t* G; bf16_t* Y; bf16_t* Mo;
    __device__ __forceinline__ void operator()(const f32x4 (&acc)[2][2][4][2], const Unit& u, int wr, int wc, int fr, int fq) const {
        const int row0 = u.pm * BM + wr * 64 + fr, col0 = u.pn * BM + wc * 32 + 8 * fq;
#pragma unroll
        for (int ai = 0; ai < 2; ++ai)
#pragma unroll
            for (int m = 0; m < 4; ++m) { const int row = row0 + ai * HALF + m * 16;
#pragma unroll
                for (int bj = 0; bj < 2; ++bj) { const int col = col0 + bj * HALF;
                    float gl[8]; unpack8(*(const u32x4*)(G + (size_t)row * 3072 + NBR * 1024 + col), gl);
                    float v[8];
#pragma unroll
                    for (int n = 0; n < 2; ++n)
#pragma unroll
                        for (int j = 0; j < 4; ++j) v[n * 4 + j] = sigm(gl[n * 4 + j]) * acc[ai][bj][m][n][j];
                    bf16_t* yp = Y + (size_t)row * DM + col;
                    if (NBR > 0) { float y[8]; unpack8(*(const u32x4*)yp, y);
#pragma unroll
                        for (int j = 0; j < 8; ++j) v[j] += y[j]; }
                    if (NBR < 2) *(u32x4*)yp = pack8(v);
                    else *(u32x4*)(Mo + (size_t)row * DM + col) = pack8(v); } }
    }
};
struct EpiLru {
    static constexpr bool PERM = true;
    const float* ba; const float* bx; const float* lam;
    const bf16_t* X; bf16_t* LA; bf16_t* BV;
    __device__ __forceinline__ void operator()(const f32x4 (&acc)[2][2][4][2], const Unit& u, int wr, int wc, int fr, int fq) const {
        const int row0 = u.pm * BM + wr * 64 + fr, ch0 = u.pn * HALF + wc * 32 + 8 * fq;
#pragma unroll
        for (int n = 0; n < 2; ++n) {
            const int ch = ch0 + 4 * n;
            const f32x4 vba = *(const f32x4*)(ba + ch), vbx = *(const f32x4*)(bx + ch), vl = *(const f32x4*)(lam + ch);
            f32x4 vsp;
#pragma unroll
            for (int j = 0; j < 4; ++j) vsp[j] = -8.0f * softplus(-vl[j]);
#pragma unroll
            for (int ai = 0; ai < 2; ++ai)
#pragma unroll
                for (int m = 0; m < 4; ++m) { const int row = row0 + ai * HALF + m * 16;
                    const u32x2 xw = *(const u32x2*)(X + (size_t)row * DM + ch);
                    const float xv[4] = {bflo(xw.x), bfhi(xw.x), bflo(xw.y), bfhi(xw.y)};
                    float la[4], bb[4];
#pragma unroll
                    for (int j = 0; j < 4; ++j) {
                        const float r = sigm(acc[ai][0][m][n][j] + vba[j]), ig = sigm(acc[ai][1][m][n][j] + vbx[j]);
                        const float l_ = r * vsp[j];
                        la[j] = l_; bb[j] = sqrtf(fmaxf(1.0f - __expf(2.0f * l_), 0.f)) * ig * xv[j]; }
                    u32x2 w0, w1; w0.x = cvt_pk_bf16(la[0], la[1]); w0.y = cvt_pk_bf16(la[2], la[3]); w1.x = cvt_pk_bf16(bb[0], bb[1]); w1.y = cvt_pk_bf16(bb[2], bb[3]);
                    *(u32x2*)(LA + (size_t)row * DM + ch) = w0;
                    *(u32x2*)(BV + (size_t)row * DM + ch) = w1; }
        }
    }
};
}

__device__ __forceinline__ void phase_mods(KP p, LAS unsigned char* lds) {
    unsigned char* const ws = ows(p); const int BID_ = obid(), GRD_ = ogrid(); (void)ws; (void)BID_; (void)GRD_;
    LAS float* s = (LAS float*)lds;
    LAS float* red = s + 17 * 1024;
    const int tid = otid(), wid = tid >> 6, lane = tid & 63;
    const float* c = p->in[1]; const float* cctx = p->in[3];
    for (int i = tid; i < 17 * 1024; i += 512) { const float v = i < 16 * 1024 ? c[i] : cctx[i - 16 * 1024]; s[i] = silu(v); }
    __syncthreads();
    float* mods = (float*)(ws + WS_MODS);
    for (int item = BID_; item < DEPTH * 144; item += GRD_) {
        const int l = item / 144, n0 = (item % 144) * 64;
        const float* W = p->in[4] + (size_t)l * 1024 * 9216 + n0 + lane;
        float acc[17];
#pragma unroll
        for (int r = 0; r < 17; ++r) acc[r] = 0.f;
        const int k0 = wid * 128;
        for (int k = k0; k < k0 + 128; k += 4) {
            const float w0 = W[(size_t)k * 9216], w1 = W[(size_t)(k + 1) * 9216], w2 = W[(size_t)(k + 2) * 9216], w3 = W[(size_t)(k + 3) * 9216];
#pragma unroll
            for (int r = 0; r < 17; ++r) { const f32x4 sv = *(const LAS f32x4*)(s + r * 1024 + k); acc[r] += sv[0] * w0 + sv[1] * w1 + sv[2] * w2 + sv[3] * w3; }
        }
#pragma unroll
        for (int r = 0; r < 17; ++r) red[(wid * 17 + r) * 64 + lane] = acc[r];
        __syncthreads();
        for (int i = tid; i < 17 * 64; i += 512) { const int r = i >> 6, cc = i & 63; float sum = p->in[5][l * 9216 + n0 + cc];
#pragma unroll
            for (int w = 0; w < 8; ++w) sum += red[(w * 17 + r) * 64 + cc];
            mods[(size_t)(l * 17 + r) * 9216 + n0 + cc] = sum; }
        __syncthreads();
    }
}

__device__ __forceinline__ void phase_convert(KP p, int l, LAS unsigned char* lds) {
    unsigned char* const ws = ows(p); const int BID_ = obid(), GRD_ = ogrid(); (void)ws; (void)BID_; (void)GRD_;
    LAS float* tile = (LAS float*)lds;
    const int tid = otid(), c = tid & 63, r0 = tid >> 6;
    for (int t = BID_; t < 8080; t += GRD_) {
        const float* src; bf16_t* dst; int N, NT, dld, map = 0, idx;
        if (t < 2816) { const int w = t / 1408; idx = t % 1408; src = p->in[8] + (size_t)(l * 2 + w) * 1024 * 5632; N = 5632; NT = 88; dst = (bf16_t*)(ws + WS_WUP) + (size_t)w * 5632 * 1024; dld = 1024; map = 1; }
        else if (t < 4224) { const int w = (t - 2816) / 704; idx = (t - 2816) % 704; src = p->in[9] + (size_t)(l * 2 + w) * 2816 * 1024; N = 1024; NT = 16; dst = (bf16_t*)(ws + WS_WDN) + (size_t)w * 1024 * 2816; dld = 2816; }
        else if (t < 7056) { idx = t - 4224; src = p->in[10] + (size_t)l * 1024 * INTOT; N = INTOT; NT = 177; dst = (bf16_t*)(ws + WS_WIN); dld = 1024; }
        else if (t < 7824) { const int w = (t - 7056) / 256; idx = (t - 7056) % 256; src = p->in[27] + (size_t)(l * 3 + w) * 1024 * 1024; N = 1024; NT = 16; dst = (bf16_t*)(ws + WS_WBR) + (size_t)w * 1024 * 1024; dld = 1024; }
        else { idx = t - 7824; src = p->in[28] + (size_t)l * 1024 * 1024; N = 1024; NT = 16; dst = (bf16_t*)(ws + WS_WOUT); dld = 1024; }
        const int kt = idx / NT, nt = idx % NT;
#pragma unroll
        for (int i = 0; i < 2; ++i) { const int r = (tid >> 4) + 32 * i, c4 = (tid & 15) * 4;
            const f32x4 v = *(const f32x4*)(src + (size_t)(kt * 64 + r) * N + nt * 64 + c4);
            tile[r * 65 + c4] = v[0]; tile[r * 65 + c4 + 1] = v[1]; tile[r * 65 + c4 + 2] = v[2]; tile[r * 65 + c4 + 3] = v[3]; }
        __syncthreads();
        { const int nn = tid >> 3, k8 = (tid & 7) * 8; int n = nt * 64 + nn;
          if (map) { const int isv = n >= DFF, j = isv ? n - DFF : n; n = (j >> 7) * 256 + (isv ? 128 : 0) + (j & 127); }
          float f[8];
#pragma unroll
          for (int e = 0; e < 8; ++e) f[e] = tile[(k8 + e) * 65 + nn];
          *(u32x4*)(dst + (size_t)n * dld + kt * 64 + k8) = pack8(f); }
        __syncthreads();
    }
    bf16_t* wl = (bf16_t*)(ws + WS_WLRU);
    for (int i = BID_ * 512 + tid; i < 2 * 16 * 2 * 4096; i += GRD_ * 512) {
        const int k = i & 63, j = (i >> 6) & 63, gate = (i >> 12) & 1, blk = (i >> 13) & 15, d = i >> 17;
        wl[i] = f2bf((gate ? p->in[21] : p->in[19])[((size_t)((l * 2 + d) * 16 + blk)) * 4096 + k * 64 + j]);
    }
}

__device__ __forceinline__ void phase_init(KP p) {
    unsigned char* const ws = ows(p); const int BID_ = obid(), GRD_ = ogrid(); (void)ws; (void)BID_; (void)GRD_;
    const int tid_ = otid(); const int gw = BID_ * 8 + (tid_ >> 6), GW = GRD_ * 8, lane = tid_ & 63;
    bf16_t* U = (bf16_t*)(ws + WS_U);
    for (int row = gw; row < TT; row += GW) {
        const float* src = row < TL ? p->in[0] + (size_t)row * DM : p->in[2] + (size_t)(row - TL) * DM;
        float* h = hrow(p, row);
        const float* sh = modp(p, 0, row, 0); const float* sc = modp(p, 0, row, 1);
#pragma unroll
        for (int j = 0; j < 4; ++j) { const int col = j * 256 + lane * 4;
            const f32x4 v = *(const f32x4*)(src + col), a = *(const f32x4*)(sh + col), b = *(const f32x4*)(sc + col);
            *(f32x4*)(h + col) = v;
            u32x2 w; w.x = cvt_pk_bf16(v[0] * (1.f + b[0]) + a[0], v[1] * (1.f + b[1]) + a[1]); w.y = cvt_pk_bf16(v[2] * (1.f + b[2]) + a[2], v[3] * (1.f + b[3]) + a[3]);
            *(u32x2*)(U + (size_t)row * DM + col) = w; }
    }
}

__device__ __forceinline__ void phase_ln(KP p, int l, int gate_idx, float resw, int ln_idx, int nl, int nshift_idx, int nrows) {
    unsigned char* const ws = ows(p); const int BID_ = obid(), GRD_ = ogrid(); (void)ws; (void)BID_; (void)GRD_;
    const int tid_ = otid(); const int gw = BID_ * 8 + (tid_ >> 6), GW = GRD_ * 8, lane = tid_ & 63;
    bf16_t* U = (bf16_t*)(ws + WS_U);
    const bf16_t* Y = (const bf16_t*)(ws + WS_YB);
    const float* lg = p->in[6] + (size_t)(l * 3 + ln_idx) * DM; const float* lb = p->in[7] + (size_t)(l * 3 + ln_idx) * DM;
    for (int rp = gw; rp < nrows / 2; rp += GW) {
        const int row = rp * 2;
        float* h0 = hrow(p, row); float* h1 = h0 + DM;
        const float* gt = modp(p, l, row, gate_idx);
        f32x4 v[2][4]; float s0 = 0.f, s1 = 0.f;
#pragma unroll
        for (int j = 0; j < 4; ++j) { const int col = j * 256 + lane * 4;
            const f32x4 gv = resw * *(const f32x4*)(gt + col);
            const f32x4 ha = *(const f32x4*)(h0 + col), hb = *(const f32x4*)(h1 + col);
            const u32x2 yaw = __builtin_nontemporal_load((const u32x2*)(Y + (size_t)row * DM + col)), ybw = __builtin_nontemporal_load((const u32x2*)(Y + (size_t)(row + 1) * DM + col));
            const f32x4 ya = (f32x4){bflo(yaw.x), bfhi(yaw.x), bflo(yaw.y), bfhi(yaw.y)}, yb = (f32x4){bflo(ybw.x), bfhi(ybw.x), bflo(ybw.y), bfhi(ybw.y)};
            v[0][j] = ALPHA * ha + gv * ya; v[1][j] = ALPHA * hb + gv * yb;
            s0 += v[0][j][0] + v[0][j][1] + v[0][j][2] + v[0][j][3]; s1 += v[1][j][0] + v[1][j][1] + v[1][j][2] + v[1][j][3]; }
        const float mu0 = wave_sum(s0, lane) * (1.f / DM), mu1 = wave_sum(s1, lane) * (1.f / DM);
        float q0 = 0.f, q1 = 0.f;
#pragma unroll
        for (int j = 0; j < 4; ++j) { v[0][j] = v[0][j] - mu0; v[1][j] = v[1][j] - mu1;
            q0 += v[0][j][0] * v[0][j][0] + v[0][j][1] * v[0][j][1] + v[0][j][2] * v[0][j][2] + v[0][j][3] * v[0][j][3];
            q1 += v[1][j][0] * v[1][j][0] + v[1][j][1] * v[1][j][1] + v[1][j][2] * v[1][j][2] + v[1][j][3] * v[1][j][3]; }
        const float r0 = rsqrtf(wave_sum(q0, lane) * (1.f / DM) + EPS), r1 = rsqrtf(wave_sum(q1, lane) * (1.f / DM) + EPS);
#pragma unroll
        for (int j = 0; j < 4; ++j) { const int col = j * 256 + lane * 4;
            const f32x4 g = *(const f32x4*)(lg + col), bb = *(const f32x4*)(lb + col);
            const f32x4 o0 = v[0][j] * r0 * g + bb, o1 = v[1][j] * r1 * g + bb;
            *(f32x4*)(h0 + col) = o0; *(f32x4*)(h1 + col) = o1;
            if (nl >= 0) { const f32x4 a = *(const f32x4*)(modp(p, nl, row, nshift_idx) + col), sc = 1.f + *(const f32x4*)(modp(p, nl, row, nshift_idx + 1) + col);
                u32x2 w; w.x = cvt_pk_bf16(o0[0] * sc[0] + a[0], o0[1] * sc[1] + a[1]); w.y = cvt_pk_bf16(o0[2] * sc[2] + a[2], o0[3] * sc[3] + a[3]);
                *(u32x2*)(U + (size_t)row * DM + col) = w;
                w.x = cvt_pk_bf16(o1[0] * sc[0] + a[0], o1[1] * sc[1] + a[1]); w.y = cvt_pk_bf16(o1[2] * sc[2] + a[2], o1[3] * sc[3] + a[3]);
                *(u32x2*)(U + (size_t)(row + 1) * DM + col) = w; } }
    }
}

__device__ __forceinline__ void conv_generic(KP p, int l, const bf16_t* src, int sld, int scol, bf16_t* dst, int nch, const float* cw, const float* cb, bool do_silu) {
    unsigned char* const ws = ows(p); const int BID_ = obid(), GRD_ = ogrid(); (void)ws; (void)BID_; (void)GRD_;
    const int colmajor = l & 1, ng = nch >> 3;
    const long total = (long)TT * ng, gstride = (long)GRD_ * 512;
    const int tid_ = otid();
    for (long it0 = (long)BID_ * 512 + tid_; it0 < total; it0 += 4 * gstride) {
        u32x4 xr[4][4]; int rowu[4], chu[4];
#pragma unroll
        for (int u = 0; u < 4; ++u) { const long it = it0 + u * gstride; const bool valid = it < total;
            const int row = valid ? (int)(it / ng) : 0, ch = valid ? (int)(it % ng) * 8 : 0;
            rowu[u] = valid ? row : -1; chu[u] = ch;
            int pos, len, stride;
            if (row < TL) { const int tok = row & (SEQ - 1); if (colmajor) { pos = tok >> 6; len = 32; stride = 64; } else { pos = tok & 63; len = 64; stride = 1; } }
            else { pos = (row - TL) & (CTXL - 1); len = CTXL; stride = 1; }
#pragma unroll
            for (int k = 0; k < 4; ++k) { const int dl = k - 2; u32x4 v = (u32x4){0u, 0u, 0u, 0u};
                if (valid && pos + dl >= 0 && pos + dl < len) v = *(const u32x4*)(src + (size_t)(row + dl * stride) * sld + scol + ch);
                xr[u][k] = v; } }
#pragma unroll
        for (int u = 0; u < 4; ++u) { if (rowu[u] < 0) continue;
            const int ch = chu[u];
            float acc[8];
            { const f32x4 b0 = *(const f32x4*)(cb + ch), b1 = *(const f32x4*)(cb + ch + 4);
#pragma unroll
              for (int e = 0; e < 4; ++e) { acc[e] = b0[e]; acc[4 + e] = b1[e]; } }
#pragma unroll
            for (int k = 0; k < 4; ++k) { float xv[8]; unpack8(xr[u][k], xv);
                const f32x4 w0 = *(const f32x4*)(cw + k * nch + ch), w1 = *(const f32x4*)(cw + k * nch + ch + 4);
#pragma unroll
                for (int e = 0; e < 4; ++e) { acc[e] += w0[e] * xv[e]; acc[4 + e] += w1[e] * xv[4 + e]; } }
            if (do_silu) {
#pragma unroll
                for (int e = 0; e < 8; ++e) acc[e] = silu(acc[e]); }
            *(u32x4*)(dst + (size_t)rowu[u] * nch + ch) = pack8(acc); }
    }
}
__device__ __forceinline__ void phase_ssd_conv(KP p, int l) {
    unsigned char* const ws = ows(p); const int BID_ = obid(), GRD_ = ogrid(); (void)ws; (void)BID_; (void)GRD_;
    const bf16_t* R = (const bf16_t*)(ws + WS_R);
    bf16_t* XC = (bf16_t*)(ws + WS_BR + BRSZ);
    conv_generic(p, l, R, 3328, 1024, XC, 2048, p->in[11] + (size_t)l * 4 * 2048, p->in[12] + (size_t)l * 2048, true);
    const float* DTS = (const float*)(ws + WS_DTS); f32x2* DTA = (f32x2*)(ws + WS_DTA);
    for (int i = BID_ * 512 + otid(); i < TT * 32; i += GRD_ * 512) {
        const int j = i & 31;
        const float dt = softplus(DTS[i] + p->in[13][l * 32 + j]);
        const float a = __expf(-dt * __expf(p->in[14][l * 32 + j]));
        DTA[i] = (f32x2){dt, a};
    }
}

__device__ __forceinline__ void phase_ssd_scan(KP p, int l, LAS unsigned char* lds) {
    unsigned char* const ws = ows(p); const int BID_ = obid(), GRD_ = ogrid(); (void)ws; (void)BID_; (void)GRD_;
    const int colmajor = l & 1;
    LAS float* xs = (LAS float*)lds;
    LAS float* Bs = xs + 2 * 32 * 128;
    LAS float* Cs = Bs + 2 * 32 * 128;
    LAS float* as_ = Cs + 2 * 32 * 128;
    LAS float* ys = as_ + 256;
    const int tid = otid(), wid = tid >> 6, lane = tid & 63, hh = wid >> 2, pq = wid & 3, pi = lane >> 4, ni = lane & 15;
    const bf16_t* XC = (const bf16_t*)(ws + WS_BR + BRSZ);
    const float* DTA = (const float*)(ws + WS_DTA);
    bf16_t* R = (bf16_t*)(ws + WS_R);
    for (int unit = BID_; unit < 256; unit += GRD_) {
        const int b = unit >> 4, d = (unit >> 3) & 1, g = (unit >> 1) & 3, half = unit & 1, head0 = g * 4 + half * 2;
        float H[4][8];
#pragma unroll
        for (int a = 0; a < 4; ++a)
#pragma unroll
            for (int c = 0; c < 8; ++c) H[a][c] = 0.f;
        u32x4 ldv[3]; f32x2 ldd = (f32x2){0.f, 0.f};
#define SSD_LOAD(chunk) do { _Pragma("unroll") for (int j = 0; j < 3; ++j) { const int idx = tid + j * 512, st = idx / 48, part = idx % 48; \
            const int row = step_row(b, d, (chunk) * 32 + st, colmajor); \
            const int col = part < 16 ? head0 * 64 + part * 8 : (part < 32 ? 1024 + g * 128 + (part - 16) * 8 : 1536 + g * 128 + (part - 32) * 8); \
            ldv[j] = *(const u32x4*)(XC + (size_t)row * 2048 + col); } \
        if (tid < 64) { const int row = step_row(b, d, (chunk) * 32 + (tid >> 1), colmajor); ldd = *(const f32x2*)(DTA + ((size_t)row * 32 + d * 16 + head0 + (tid & 1)) * 2); } } while (0)
#define SSD_STORE(buf) do { _Pragma("unroll") for (int j = 0; j < 3; ++j) { const int idx = tid + j * 512, st = idx / 48, part = idx % 48; \
            LAS float* dp = (part < 16 ? xs + part * 8 : (part < 32 ? Bs + (part - 16) * 8 : Cs + (part - 32) * 8)) + ((buf) * 32 + st) * 128; \
            float f[8]; unpack8(ldv[j], f); *(LAS f32x4*)dp = (f32x4){f[0], f[1], f[2], f[3]}; *(LAS f32x4*)(dp + 4) = (f32x4){f[4], f[5], f[6], f[7]}; } \
        if (tid < 64) *(LAS f32x2*)(as_ + (buf) * 128 + tid * 2) = ldd; } while (0)
        SSD_LOAD(0); SSD_STORE(0);
        __syncthreads();
        for (int c = 0; c < 72; ++c) {
            const int buf = c & 1;
            if (c + 1 < 72) SSD_LOAD(c + 1);
            for (int i = 0; i < 32; ++i) {
                const f32x2 da = *(const LAS f32x2*)(as_ + buf * 128 + (i * 2 + hh) * 2);
                const int rb = (buf * 32 + i) * 128;
                f32x4 xv = *(const LAS f32x4*)(xs + rb + hh * 64 + pq * 16 + pi * 4);
                const f32x4 b0 = *(const LAS f32x4*)(Bs + rb + ni * 8), b1 = *(const LAS f32x4*)(Bs + rb + ni * 8 + 4);
                const f32x4 c0 = *(const LAS f32x4*)(Cs + rb + ni * 8), c1 = *(const LAS f32x4*)(Cs + rb + ni * 8 + 4);
                xv = xv * da.x;
                const float a = da.y;
                float y[4];
#pragma unroll
                for (int pp = 0; pp < 4; ++pp) { float acc = 0.f;
#pragma unroll
                    for (int nn = 0; nn < 4; ++nn) { H[pp][nn] = a * H[pp][nn] + xv[pp] * b0[nn]; acc += c0[nn] * H[pp][nn]; }
#pragma unroll
                    for (int nn = 0; nn < 4; ++nn) { H[pp][4 + nn] = a * H[pp][4 + nn] + xv[pp] * b1[nn]; acc += c1[nn] * H[pp][4 + nn]; }
                    y[pp] = sum16(acc); }
                if (ni == 0) *(LAS f32x4*)(ys + i * 128 + hh * 64 + pq * 16 + pi * 4) = (f32x4){y[0], y[1], y[2], y[3]};
            }
            __syncthreads();
            { const int st = tid >> 4, part = tid & 15; const int row = step_row(b, d, c * 32 + st, colmajor);
              const f32x4 v0 = *(const LAS f32x4*)(ys + st * 128 + part * 8), v1 = *(const LAS f32x4*)(ys + st * 128 + part * 8 + 4);
              u32x4 w; w.x = cvt_pk_bf16(v0[0], v0[1]); w.y = cvt_pk_bf16(v0[2], v0[3]); w.z = cvt_pk_bf16(v1[0], v1[1]); w.w = cvt_pk_bf16(v1[2], v1[3]);
              *(u32x4*)(R + (size_t)row * 3328 + 1024 + d * 1024 + head0 * 64 + part * 8) = w; }
            if (c + 1 < 72) SSD_STORE(buf ^ 1);
            __syncthreads();
        }
#undef SSD_LOAD
#undef SSD_STORE
    }
}


__device__ __forceinline__ f32x4 mma16(const LAS bf16_t* A, int lda, int row0, const LAS bf16_t* Bt, int ldb, int col0, int ksteps, f32x4 acc, int lane) {
    const int r = lane & 15, q = lane >> 4;
    for (int kk = 0; kk < ksteps; ++kk) {
        const bf16x8 a = *(const LAS bf16x8*)(A + (row0 + r) * lda + kk * 32 + q * 8);
        const bf16x8 b = *(const LAS bf16x8*)(Bt + (col0 + r) * ldb + kk * 32 + q * 8);
        acc = __builtin_amdgcn_mfma_f32_16x16x32_bf16(a, b, acc, 0, 0, 0);
    }
    return acc;
}

__device__ __forceinline__ void phase_ssd_chunk(KP p, int l, LAS unsigned char* lds) {
    unsigned char* const ws = ows(p); const int BID_ = obid(), GRD_ = ogrid();
    const int colmajor = l & 1;
    LAS bf16_t* Cc = (LAS bf16_t*)lds;
    LAS bf16_t* Bc = Cc + 8704;
    LAS bf16_t* BT = Bc + 8704;
    LAS bf16_t* XT = BT + 9216;
    LAS bf16_t* Ms = XT + 9216;
    LAS bf16_t* Hs = Ms + 9216;
    LAS float* cs = (LAS float*)(lds + 124928);
    LAS float* dts = cs + 128;
    LAS bf16_t* Xn = Ms;
    const int tid = otid(), wid = tid >> 6, lane = tid & 63, r16 = lane & 15, quad = lane >> 4, hh = wid >> 2, wq = wid & 3;
    const bf16_t* XC = (const bf16_t*)(ws + WS_BR + BRSZ);
    const float* DTA = (const float*)(ws + WS_DTA);
    bf16_t* R = (bf16_t*)(ws + WS_R);
    for (int unit = BID_; unit < 256; unit += GRD_) {
        const int ux = unit & 7, uy = unit >> 3; const int b = uy >> 1, d = ux >> 2, g = ux & 3, half = uy & 1, head0 = g * 4 + half * 2;
        for (int i = tid; i < 8704; i += 512) ((LAS unsigned*)Hs)[i] = 0u;
        for (int i = tid; i < 4608; i += 512) ((LAS unsigned*)Ms)[i] = 0u;
        f32x4 Hacc[8];
#pragma unroll
        for (int i = 0; i < 8; ++i) Hacc[i] = (f32x4){0.f, 0.f, 0.f, 0.f};
        const float expAcs = __expf(p->in[14][l * 32 + d * 16 + head0 + (wid & 1)]);
        u32x4 ldv[6]; float dtn = 0.f;
#define SC_LOAD(chunk) do { _Pragma("unroll") for (int j = 0; j < 6; ++j) { const int idx = tid + j * 512, s_ = idx / 48, part = idx % 48; \
            const int row = step_row(b, d, (chunk) * 64 + s_, colmajor); \
            const int col = part < 16 ? head0 * 64 + part * 8 : (part < 32 ? 1024 + g * 128 + (part - 16) * 8 : 1536 + g * 128 + (part - 32) * 8); \
            ldv[j] = *(const u32x4*)(XC + (size_t)row * 2048 + col); } \
        if (wid < 2) { const int row = step_row(b, d, (chunk) * 64 + lane, colmajor); dtn = DTA[((size_t)row * 32 + d * 16 + head0 + wid) * 2]; } } while (0)
#define SC_STORE1() do { _Pragma("unroll") for (int j = 0; j < 6; ++j) { const int idx = tid + j * 512, s_ = idx / 48, part = idx % 48; \
            LAS bf16_t* dp = (part < 16 ? Xn + part * 8 : (part < 32 ? Bc + (part - 16) * 8 : Cc + (part - 32) * 8)) + s_ * 136; \
            *(LAS u32x4*)dp = ldv[j]; } \
        if (wid < 2) { dts[wid * 64 + lane] = dtn; float v = -dtn * expAcs; \
            _Pragma("unroll") for (int off = 1; off < 64; off <<= 1) { const float t_ = __int_as_float(__builtin_amdgcn_ds_bpermute((lane >= off ? lane - off : lane) << 2, __float_as_int(v))); if (lane >= off) v += t_; } \
            cs[wid * 64 + lane] = v; } } while (0)
#define SC_STORE2() do { _Pragma("unroll") for (int i = 0; i < 2; ++i) { const int id = tid + i * 512, prow = id & 127, s0 = (id >> 7) * 8; \
            float fx[8], fb[8]; \
            _Pragma("unroll") for (int e = 0; e < 8; ++e) { fx[e] = bf2f(Xn[(s0 + e) * 136 + prow]); fb[e] = bf2f(Bc[(s0 + e) * 136 + prow]); } \
            const f32x4 d0 = *(const LAS f32x4*)(dts + (prow >> 6) * 64 + s0), d1 = *(const LAS f32x4*)(dts + (prow >> 6) * 64 + s0 + 4); \
            _Pragma("unroll") for (int e = 0; e < 4; ++e) { fx[e] *= d0[e]; fx[4 + e] *= d1[e]; } \
            *(LAS u32x4*)(XT + prow * 72 + s0) = pack8(fx); *(LAS u32x4*)(BT + prow * 72 + s0) = pack8(fb); } } while (0)
        SC_LOAD(0); SC_STORE1();
        __syncthreads();
        SC_STORE2();
        __syncthreads();
        for (int c = 0; c < 36; ++c) {
            if (c + 1 < 36) SC_LOAD(c + 1);
            { const int lt = wid >> 1;
#pragma unroll
              for (int t2 = 0; t2 < 2; ++t2) { const int st = (wid & 1) * 2 + t2;
                  if (st <= lt) {
                      f32x4 acc = (f32x4){0.f, 0.f, 0.f, 0.f};
                      acc = mma16(Bc, 136, st * 16, Cc, 136, lt * 16, 4, acc, lane);
                      const int l_ = lt * 16 + r16, s0_ = st * 16 + quad * 4;
                      float csl[2], css[2][4];
#pragma unroll
                      for (int h2 = 0; h2 < 2; ++h2) { csl[h2] = cs[h2 * 64 + l_];
                          const f32x4 c4 = *(const LAS f32x4*)(cs + h2 * 64 + s0_); css[h2][0] = c4[0]; css[h2][1] = c4[1]; css[h2][2] = c4[2]; css[h2][3] = c4[3]; }
#pragma unroll
                      for (int h2 = 0; h2 < 2; ++h2) { float m[4];
#pragma unroll
                          for (int j = 0; j < 4; ++j) m[j] = (s0_ + j <= l_) ? acc[j] * __expf(csl[h2] - css[h2][j]) : 0.f;
                          u32x2 w; w.x = cvt_pk_bf16(m[0], m[1]); w.y = cvt_pk_bf16(m[2], m[3]);
                          *(LAS u32x2*)(Ms + (h2 * 64 + l_) * 72 + s0_) = w; } }
                  else { const int l_ = lt * 16 + r16, s0_ = st * 16 + quad * 4;
                      *(LAS u32x2*)(Ms + l_ * 72 + s0_) = (u32x2){0u, 0u}; *(LAS u32x2*)(Ms + (64 + l_) * 72 + s0_) = (u32x2){0u, 0u}; } } }
            __syncthreads();
            { const float e = __expf(cs[hh * 64 + wq * 16 + r16]);
              bf16x8 bc[4], bm[2];
#pragma unroll
              for (int kk = 0; kk < 4; ++kk) bc[kk] = *(const LAS bf16x8*)(Cc + (wq * 16 + r16) * 136 + kk * 32 + quad * 8);
#pragma unroll
              for (int kk = 0; kk < 2; ++kk) bm[kk] = *(const LAS bf16x8*)(Ms + (hh * 64 + wq * 16 + r16) * 72 + kk * 32 + quad * 8);
              const int row = step_row(b, d, c * 64 + wq * 16 + r16, colmajor);
              bf16_t* op = R + (size_t)row * 3328 + 1024 + d * 1024 + (head0 + hh) * 64 + quad * 4;
#pragma unroll
              for (int pt = 0; pt < 4; ++pt) { f32x4 a = (f32x4){0.f, 0.f, 0.f, 0.f};
#pragma unroll
                  for (int kk = 0; kk < 4; ++kk) a = __builtin_amdgcn_mfma_f32_16x16x32_bf16(*(const LAS bf16x8*)(Hs + (hh * 64 + pt * 16 + r16) * 136 + kk * 32 + quad * 8), bc[kk], a, 0, 0, 0);
                  a = a * e;
#pragma unroll
                  for (int kk = 0; kk < 2; ++kk) a = __builtin_amdgcn_mfma_f32_16x16x32_bf16(*(const LAS bf16x8*)(XT + (hh * 64 + pt * 16 + r16) * 72 + kk * 32 + quad * 8), bm[kk], a, 0, 0, 0);
                  u32x2 w; w.x = cvt_pk_bf16(a[0], a[1]); w.y = cvt_pk_bf16(a[2], a[3]);
                  *(u32x2*)(op + pt * 16) = w; } }
            __syncthreads();
            { const float cse = cs[hh * 64 + 63], dec = __expf(cse);
              bf16x8 aw[2];
#pragma unroll
              for (int kk = 0; kk < 2; ++kk) { const bf16x8 a = *(const LAS bf16x8*)(XT + (hh * 64 + wq * 16 + r16) * 72 + kk * 32 + quad * 8);
#pragma unroll
                  for (int e2 = 0; e2 < 8; ++e2) { const float w_ = __expf(cse - cs[hh * 64 + kk * 32 + quad * 8 + e2]);
                      aw[kk][e2] = (short)f2bf(bf2f((bf16_t)a[e2]) * w_); } }
#pragma unroll
              for (int nt = 0; nt < 8; ++nt) { f32x4 h = Hacc[nt] * dec;
#pragma unroll
                  for (int kk = 0; kk < 2; ++kk) { const bf16x8 bb = *(const LAS bf16x8*)(BT + (nt * 16 + r16) * 72 + kk * 32 + quad * 8);
                      h = __builtin_amdgcn_mfma_f32_16x16x32_bf16(aw[kk], bb, h, 0, 0, 0); }
                  Hacc[nt] = h; }
#pragma unroll
              for (int nt = 0; nt < 8; ++nt)
#pragma unroll
                  for (int j = 0; j < 4; ++j) Hs[(hh * 64 + wq * 16 + quad * 4 + j) * 136 + nt * 16 + r16] = f2bf(Hacc[nt][j]); }
            __syncthreads();
            if (c + 1 < 36) SC_STORE1();
            __syncthreads();
            if (c + 1 < 36) SC_STORE2();
            __syncthreads();
        }
#undef SC_LOAD
#undef SC_STORE1
#undef SC_STORE2
    }
}

__device__ __forceinline__ void phase_ssd_combine(KP p, int l) {
    unsigned char* const ws = ows(p); const int BID_ = obid(), GRD_ = ogrid(); (void)ws; (void)BID_; (void)GRD_;
    const int tid_ = otid(); const int gw = BID_ * 8 + (tid_ >> 6), GW = GRD_ * 8, lane = tid_ & 63;
    const bf16_t* R = (const bf16_t*)(ws + WS_R); const bf16_t* XC = (const bf16_t*)(ws + WS_BR + BRSZ);
    bf16_t* BR0 = (bf16_t*)(ws + WS_BR);
    const float* dsk = p->in[15] + l * 32; const float* ng = p->in[16] + (size_t)l * 1024;
    for (int rp = gw; rp < TT / 2; rp += GW) {
        f32x4 v[2][4]; float q[2] = {0.f, 0.f};
#pragma unroll
        for (int r = 0; r < 2; ++r) { const int row = rp * 2 + r;
#pragma unroll
            for (int j = 0; j < 4; ++j) { const int col = j * 256 + lane * 4, head = col >> 6;
                const u32x2 z = __builtin_nontemporal_load((const u32x2*)(R + (size_t)row * 3328 + col)), yf = __builtin_nontemporal_load((const u32x2*)(R + (size_t)row * 3328 + 1024 + col)), yb = __builtin_nontemporal_load((const u32x2*)(R + (size_t)row * 3328 + 2048 + col));
                const u32x2 x = __builtin_nontemporal_load((const u32x2*)(XC + (size_t)row * 2048 + col));
                const float dd = dsk[head] + dsk[16 + head];
                v[r][j][0] = (bflo(yf.x) + bflo(yb.x) + dd * bflo(x.x)) * silu(bflo(z.x));
                v[r][j][1] = (bfhi(yf.x) + bfhi(yb.x) + dd * bfhi(x.x)) * silu(bfhi(z.x));
                v[r][j][2] = (bflo(yf.y) + bflo(yb.y) + dd * bflo(x.y)) * silu(bflo(z.y));
                v[r][j][3] = (bfhi(yf.y) + bfhi(yb.y) + dd * bfhi(x.y)) * silu(bfhi(z.y));
                q[r] += v[r][j][0] * v[r][j][0] + v[r][j][1] * v[r][j][1] + v[r][j][2] * v[r][j][2] + v[r][j][3] * v[r][j][3]; } }
        const float rs0 = rsqrtf(wave_sum(q[0], lane) * (1.f / 1024.f) + EPS), rs1 = rsqrtf(wave_sum(q[1], lane) * (1.f / 1024.f) + EPS);
#pragma unroll
        for (int j = 0; j < 4; ++j) { const int col = j * 256 + lane * 4; const f32x4 g = *(const f32x4*)(ng + col);
            u32x2 w; w.x = cvt_pk_bf16(v[0][j][0] * rs0 * g[0], v[0][j][1] * rs0 * g[1]); w.y = cvt_pk_bf16(v[0][j][2] * rs0 * g[2], v[0][j][3] * rs0 * g[3]);
            *(u32x2*)(BR0 + (size_t)(rp * 2) * DM + col) = w;
            w.x = cvt_pk_bf16(v[1][j][0] * rs1 * g[0], v[1][j][1] * rs1 * g[1]); w.y = cvt_pk_bf16(v[1][j][2] * rs1 * g[2], v[1][j][3] * rs1 * g[3]);
            *(u32x2*)(BR0 + (size_t)(rp * 2 + 1) * DM + col) = w; }
    }
}
__device__ __forceinline__ void phase_lru_scan(KP p, int l, int d, LAS unsigned char* lds) {
    unsigned char* const ws = ows(p); const int BID_ = obid(), GRD_ = ogrid(); (void)ws; (void)BID_; (void)GRD_;
    const int colmajor = l & 1;
    LAS float* segE = (LAS float*)lds;
    LAS float* segL = segE + 512;
    const int tid = otid(), wid = tid >> 6, lane = tid & 63;
    const bf16_t* LA = (const bf16_t*)(ws + WS_YB); const bf16_t* BV = LA + (size_t)TT * DM;
    bf16_t* BR1 = (bf16_t*)(ws + WS_BR + BRSZ);
    const bf16_t* R = (const bf16_t*)(ws + WS_R);
    for (int unit = BID_; unit < 256; unit += GRD_) {
        const int b = unit >> 4, ch = (unit & 15) * 64 + lane;
        const int s0 = wid * 288;
        float h = 0.f, L = 0.f;
#pragma unroll 16
        for (int s = s0; s < s0 + 288; ++s) { const size_t o = (size_t)step_row(b, d, s, colmajor) * DM + ch;
            const float la = bf2f(LA[o]), bb = bf2f(BV[o]);
            h = __expf(la) * h + bb; L += la; }
        segE[wid * 64 + lane] = h; segL[wid * 64 + lane] = L;
        __syncthreads();
        h = 0.f;
        for (int w = 0; w < wid; ++w) h = __expf(segL[w * 64 + lane]) * h + segE[w * 64 + lane];
#pragma unroll 16
        for (int s = s0; s < s0 + 288; ++s) { const int row = step_row(b, d, s, colmajor); const size_t o = (size_t)row * DM + ch;
            const float la = bf2f(LA[o]), bb = bf2f(BV[o]);
            h = __expf(la) * h + bb;
            if (d == 0) BR1[o] = f2bf(h);
            else { const float gv = bf2f(R[(size_t)row * 2048 + 1024 + ch]); BR1[o] = f2bf((bf2f(BR1[o]) + h) * gelu_tanh(gv)); } }
        __syncthreads();
    }
}


__device__ __forceinline__ void phase_lru_fused(KP p, int l, LAS unsigned char* lds) {
    unsigned char* const ws = ows(p); const int BID_ = obid(), GRD_ = ogrid();
    const int colmajor = l & 1, linelat = colmajor ? 32 : 64;
    LAS bf16_t* raw = (LAS bf16_t*)lds;
    LAS bf16_t* xc  = raw + 4864;
    LAS bf16_t* wt  = xc + 4608;
    LAS float* as_ = (LAS float*)(lds + 37376);
    LAS float* bs_ = as_ + 8192;
    const int tid = otid(), wid = tid >> 6, lane = tid & 63, r16 = lane & 15, quad = lane >> 4, cs_ = tid >> 3, cg = tid & 7;
    const bf16_t* R = (const bf16_t*)(ws + WS_YB);
    bf16_t* BR1 = (bf16_t*)(ws + WS_BR + BRSZ);
    const bf16_t* WL = (const bf16_t*)(ws + WS_WLRU);
    for (int unit = BID_; unit < 256; unit += GRD_) {
        const int b = unit >> 4, blk = unit & 15, ch0 = blk * 64;
        float cwv[4][8], cbv[8];
#pragma unroll
        for (int e = 0; e < 8; ++e) { cbv[e] = p->in[18][l * 1024 + ch0 + cg * 8 + e];
#pragma unroll
            for (int k = 0; k < 4; ++k) cwv[k][e] = p->in[17][(size_t)(l * 4 + k) * 1024 + ch0 + cg * 8 + e]; }
#define LRU_ROW(isctx, q) ((isctx) ? TL + b * CTXL + (q) : b * SEQ + (colmajor ? (((q) & 31) * 64 + ((q) >> 5)) : (q)))
#define LRU_CHUNK(cc) const int isctx = (cc) < 4; const int oc = d ? (isctx ? 3 - (cc) : 35 - (cc)) : (isctx ? (cc) : (cc) - 4); const int q0 = oc * 64; const int seglen = isctx ? CTXL : SEQ;
#define LRU_LOAD(cc) do { LRU_CHUNK(cc) \
            _Pragma("unroll") for (int j = 0; j < 2; ++j) { const int idx = tid + j * 512; const int i_ = idx >> 3, kp = idx & 7; const int q = q0 - 2 + i_; \
                u32x4 v_ = (u32x4){0u, 0u, 0u, 0u}; \
                if (idx < 536 && q >= 0 && q < seglen) v_ = *(const u32x4*)(R + (size_t)LRU_ROW(isctx, q) * 2048 + ch0 + kp * 8); \
                ldx[j] = v_; } } while (0)
        for (int d = 0; d < 2; ++d) {
            __syncthreads();
            for (int i = tid; i < 1024; i += 512) { const int gate = i >> 9, j = (i >> 3) & 63, kp = i & 7;
                *(LAS u32x4*)(wt + (gate * 64 + j) * 72 + kp * 8) = *(const u32x4*)(WL + ((size_t)((d * 16 + blk) * 2 + gate)) * 4096 + j * 64 + kp * 8); }
            const int st = wid & 3, jt0 = (wid >> 2) * 2;
            float ba[2], bx[2], vsp[2];
#pragma unroll
            for (int e = 0; e < 2; ++e) { const int c_ = (l * 2 + d) * 1024 + ch0 + (jt0 + e) * 16 + r16;
                ba[e] = p->in[20][c_]; bx[e] = p->in[22][c_]; vsp[e] = -8.0f * softplus(-p->in[23][c_]); }
            float h = 0.f;
            u32x4 ldx[2];
            u32x4 hf_cur = (u32x4){0u, 0u, 0u, 0u}, g_cur = hf_cur, hf_nxt = hf_cur, g_nxt = hf_cur;
            LRU_LOAD(0);
            for (int cc = 0; cc <= 36; ++cc) {
                if (cc < 36) {
#pragma unroll
                    for (int j = 0; j < 2; ++j) { const int idx = tid + j * 512; if (idx < 536) *(LAS u32x4*)(raw + (idx >> 3) * 72 + (idx & 7) * 8) = ldx[j]; } }
                __syncthreads();
                if (cc < 36) {
                    LRU_CHUNK(cc)
                    if (cc + 1 < 36) LRU_LOAD(cc + 1);
                    if (d == 1) { const int rowo = LRU_ROW(isctx, q0 + cs_);
                        hf_nxt = *(const u32x4*)(BR1 + (size_t)rowo * DM + ch0 + cg * 8); g_nxt = *(const u32x4*)(R + (size_t)rowo * 2048 + 1024 + ch0 + cg * 8); }
                    if (wid != 0) {
                        const int line = isctx ? CTXL : linelat;
#pragma unroll
                        for (int rep = 0; rep < 2; ++rep) { const int item = rep ? tid + 384 : tid - 64;
                            if (rep == 0 || tid < 128) { const int cr = item >> 3, qme = q0 + cr;
                                float acc[8];
#pragma unroll
                                for (int e = 0; e < 8; ++e) acc[e] = cbv[e];
#pragma unroll
                                for (int k = 0; k < 4; ++k) { const int qq = qme + k - 2;
                                    if (qq >= 0 && qq < seglen && (qq & ~(line - 1)) == (qme & ~(line - 1))) { float xv[8]; unpack8(*(const LAS u32x4*)(raw + (cr + k) * 72 + cg * 8), xv);
#pragma unroll
                                        for (int e = 0; e < 8; ++e) acc[e] += cwv[k][e] * xv[e]; } }
                                *(LAS u32x4*)(xc + cr * 72 + cg * 8) = pack8(acc); } } } }
                if (wid == 0 && cc > 0) { LAS float* ap = as_ + ((cc - 1) & 1) * 4096; LAS float* bp = bs_ + ((cc - 1) & 1) * 4096;
                    for (int t0 = 0; t0 < 64; t0 += 16) { float av[16], bv[16];
#pragma unroll
                        for (int t = 0; t < 16; ++t) { const int s_ = d ? 63 - (t0 + t) : (t0 + t); av[t] = ap[s_ * 64 + lane]; bv[t] = bp[s_ * 64 + lane]; }
#pragma unroll
                        for (int t = 0; t < 16; ++t) { h = av[t] * h + bv[t]; bv[t] = h; }
#pragma unroll
                        for (int t = 0; t < 16; ++t) { const int s_ = d ? 63 - (t0 + t) : (t0 + t); bp[s_ * 64 + lane] = bv[t]; } } }
                __syncthreads();
                if (cc < 36) {
                    LAS float* ap = as_ + (cc & 1) * 4096; LAS float* bp = bs_ + (cc & 1) * 4096;
#pragma unroll
                    for (int e = 0; e < 2; ++e) { f32x4 ga = (f32x4){0.f, 0.f, 0.f, 0.f}, gx = (f32x4){0.f, 0.f, 0.f, 0.f};
                        ga = mma16(xc, 72, st * 16, wt, 72, (jt0 + e) * 16, 2, ga, lane);
                        gx = mma16(xc, 72, st * 16, wt + 64 * 72, 72, (jt0 + e) * 16, 2, gx, lane);
                        const int ch = (jt0 + e) * 16 + r16;
#pragma unroll
                        for (int j4 = 0; j4 < 4; ++j4) { const int s_ = st * 16 + quad * 4 + j4;
                            const float x_ = bf2f(xc[s_ * 72 + ch]);
                            const float r_ = sigm(ga[j4] + ba[e]), ig = sigm(gx[j4] + bx[e]);
                            const float a_ = __expf(r_ * vsp[e]);
                            ap[s_ * 64 + ch] = a_; bp[s_ * 64 + ch] = sqrtf(fmaxf(1.0f - a_ * a_, 0.f)) * ig * x_; } } }
                if (cc > 0) {
                    LRU_CHUNK(cc - 1)
                    (void)seglen;
                    const int rowo = LRU_ROW(isctx, q0 + cs_);
                    const LAS float* bp = bs_ + ((cc - 1) & 1) * 4096;
                    const f32x4 h0 = *(const LAS f32x4*)(bp + cs_ * 64 + cg * 8), h1 = *(const LAS f32x4*)(bp + cs_ * 64 + cg * 8 + 4);
                    float o[8] = {h0[0], h0[1], h0[2], h0[3], h1[0], h1[1], h1[2], h1[3]};
                    if (d == 1) { float hf[8], gg[8]; unpack8(hf_cur, hf); unpack8(g_cur, gg);
#pragma unroll
                        for (int e = 0; e < 8; ++e) o[e] = (hf[e] + o[e]) * gelu_tanh(gg[e]); }
                    *(u32x4*)(BR1 + (size_t)rowo * DM + ch0 + cg * 8) = pack8(o); }
                hf_cur = hf_nxt; g_cur = g_nxt;
            }
        }
#undef LRU_ROW
#undef LRU_CHUNK
#undef LRU_LOAD
    }
}

__device__ __forceinline__ void phase_gla_decay(KP p, int l) {
    unsigned char* const ws = ows(p); const int BID_ = obid(), GRD_ = ogrid(); (void)ws; (void)BID_; (void)GRD_;
    const int tid_ = otid(); const int gw = BID_ * 8 + (tid_ >> 6), GW = GRD_ * 8, lane = tid_ & 63;
    const float* ALS = (const float*)(ws + WS_ALS);
    bf16_t* LAg = (bf16_t*)(ws + WS_YB);
    for (int it = gw; it < TT * 2; it += GW) {
        const int row = it >> 1, d = it & 1, c0 = lane * 8;
        const float* wg = p->in[24] + (size_t)(l * 2 + d) * 16 * 512; const float* bg = p->in[25] + (size_t)(l * 2 + d) * 512;
        float acc[8];
#pragma unroll
        for (int e = 0; e < 8; ++e) acc[e] = bg[c0 + e];
#pragma unroll
        for (int r = 0; r < 16; ++r) { const float a = ALS[(size_t)row * 32 + d * 16 + r];
            const f32x4 w0 = *(const f32x4*)(wg + r * 512 + c0), w1 = *(const f32x4*)(wg + r * 512 + c0 + 4);
#pragma unroll
            for (int e = 0; e < 4; ++e) { acc[e] += a * w0[e]; acc[4 + e] += a * w1[e]; } }
#pragma unroll
        for (int e = 0; e < 8; ++e) acc[e] = -softplus(-acc[e]) * (1.f / 16.f);
        *(u32x4*)(LAg + ((size_t)d * TT + row) * 512 + c0) = pack8(acc);
    }
}

__device__ __forceinline__ void phase_gla_scan(KP p, int l, LAS unsigned char* lds) {
    unsigned char* const ws = ows(p); const int BID_ = obid(), GRD_ = ogrid(); (void)ws; (void)BID_; (void)GRD_;
    const int colmajor = l & 1;
    LAS float* qs = (LAS float*)lds;
    LAS float* ks = qs + 2 * 16 * 128;
    LAS float* vs = ks + 2 * 16 * 128;
    LAS float* al = vs + 2 * 16 * 128;
    LAS float* os = al + 2 * 16 * 128;
    const int tid = otid(), wid = tid >> 6, lane = tid & 63, kg = lane & 15, vg = wid * 4 + (lane >> 4);
    const bf16_t* R = (const bf16_t*)(ws + WS_R);
    const bf16_t* LAg = (const bf16_t*)(ws + WS_YB);
    for (int unit = BID_; unit < 256; unit += GRD_) {
        const int b = unit >> 4, d = (unit >> 3) & 1, head = (unit >> 1) & 3, vh = unit & 1;
        bf16_t* O = d ? (bf16_t*)(ws + WS_YB + BRSZ) : (bf16_t*)(ws + WS_BR + 2 * BRSZ);
        float S[8][4];
#pragma unroll
        for (int a = 0; a < 8; ++a)
#pragma unroll
            for (int c = 0; c < 4; ++c) S[a][c] = 0.f;
        u32x4 ldv[2];
#define GLA_LOAD(chunk) do { _Pragma("unroll") for (int j = 0; j < 2; ++j) { const int idx = tid + j * 512, st = idx >> 6, part = idx & 63, which = part >> 4, pp = part & 15; \
            const int row = step_row(b, d, (chunk) * 16 + st, colmajor); \
            const bf16_t* sp = which == 0 ? R + (size_t)row * 3328 + head * 128 + pp * 8 : (which == 1 ? R + (size_t)row * 3328 + 512 + head * 128 + pp * 8 : \
                (which == 2 ? R + (size_t)row * 3328 + 1024 + head * 256 + vh * 128 + pp * 8 : LAg + ((size_t)d * TT + row) * 512 + head * 128 + pp * 8)); \
            ldv[j] = *(const u32x4*)sp; } } while (0)
#define GLA_STORE(buf) do { _Pragma("unroll") for (int j = 0; j < 2; ++j) { const int idx = tid + j * 512, st = idx >> 6, part = idx & 63, which = part >> 4, pp = part & 15; \
            LAS float* dp = (which == 0 ? qs : (which == 1 ? ks : (which == 2 ? vs : al))) + ((buf) * 16 + st) * 128 + pp * 8; \
            float f[8]; unpack8(ldv[j], f); \
            if (which == 0) { _Pragma("unroll") for (int e = 0; e < 8; ++e) f[e] *= 0.08838834764831845f; } \
            if (which == 3) { _Pragma("unroll") for (int e = 0; e < 8; ++e) f[e] = __expf(f[e]); } \
            *(LAS f32x4*)dp = (f32x4){f[0], f[1], f[2], f[3]}; *(LAS f32x4*)(dp + 4) = (f32x4){f[4], f[5], f[6], f[7]}; } } while (0)
        GLA_LOAD(0); GLA_STORE(0);
        __syncthreads();
        for (int c = 0; c < 144; ++c) {
            const int buf = c & 1;
            if (c + 1 < 144) GLA_LOAD(c + 1);
            for (int i = 0; i < 16; ++i) {
                const int rb = (buf * 16 + i) * 128;
                const f32x4 a0 = *(const LAS f32x4*)(al + rb + kg * 8), a1 = *(const LAS f32x4*)(al + rb + kg * 8 + 4);
                const f32x4 k0 = *(const LAS f32x4*)(ks + rb + kg * 8), k1 = *(const LAS f32x4*)(ks + rb + kg * 8 + 4);
                const f32x4 q0 = *(const LAS f32x4*)(qs + rb + kg * 8), q1 = *(const LAS f32x4*)(qs + rb + kg * 8 + 4);
                const f32x4 vv = *(const LAS f32x4*)(vs + rb + vg * 4);
                float o[4] = {0.f, 0.f, 0.f, 0.f};
#pragma unroll
                for (int kk = 0; kk < 4; ++kk)
#pragma unroll
                    for (int e = 0; e < 4; ++e) { S[kk][e] = a0[kk] * S[kk][e] + k0[kk] * vv[e]; o[e] += q0[kk] * S[kk][e]; }
#pragma unroll
                for (int kk = 0; kk < 4; ++kk)
#pragma unroll
                    for (int e = 0; e < 4; ++e) { S[4 + kk][e] = a1[kk] * S[4 + kk][e] + k1[kk] * vv[e]; o[e] += q1[kk] * S[4 + kk][e]; }
#pragma unroll
                for (int e = 0; e < 4; ++e) o[e] = sum16(o[e]);
                if (kg == 0) *(LAS f32x4*)(os + i * 128 + vg * 4) = (f32x4){o[0], o[1], o[2], o[3]};
            }
            __syncthreads();
            if (tid < 256) { const int st = tid >> 4, part = tid & 15; const int row = step_row(b, d, c * 16 + st, colmajor);
              const f32x4 v0 = *(const LAS f32x4*)(os + st * 128 + part * 8), v1 = *(const LAS f32x4*)(os + st * 128 + part * 8 + 4);
              u32x4 w; w.x = cvt_pk_bf16(v0[0], v0[1]); w.y = cvt_pk_bf16(v0[2], v0[3]); w.z = cvt_pk_bf16(v1[0], v1[1]); w.w = cvt_pk_bf16(v1[2], v1[3]);
              *(u32x4*)(O + (size_t)row * DM + head * 256 + vh * 128 + part * 8) = w; }
            if (c + 1 < 144) GLA_STORE(buf ^ 1);
            __syncthreads();
        }
#undef GLA_LOAD
#undef GLA_STORE
    }
}


__device__ __forceinline__ void phase_gla_chunk(KP p, int l, LAS unsigned char* lds) {
    unsigned char* const ws = ows(p); const int BID_ = obid(), GRD_ = ogrid();
    const int colmajor = l & 1;
    LAS bf16_t* Qin = (LAS bf16_t*)lds;
    LAS bf16_t* Kin = Qin + 8704;
    LAS bf16_t* KstT = Kin + 8704;
    LAS bf16_t* VT = KstT + 9216;
    LAS bf16_t* LAr = VT + 9216;
    LAS bf16_t* Att = LAr;
    LAS float* als = (LAS float*)(LAr + 4608);
    LAS bf16_t* STs = LAr + 8704;
    LAS float* tot = (LAS float*)(lds + 123904);
    LAS float* blast = tot + 512;
    const int tid = otid(), wid = tid >> 6, lane = tid & 63, r16 = lane & 15, quad = lane >> 4, kch = tid & 127, seg = tid >> 7;
    const bf16_t* R = (const bf16_t*)(ws + WS_R);
    const float* ALS = (const float*)(ws + WS_ALS);
    for (int unit = BID_; unit < 256; unit += GRD_) {
        const int ux = unit & 7, uy = unit >> 3; const int b = uy >> 1, d = ux >> 2, head = ux & 3, vh = uy & 1;
        bf16_t* O = d ? (bf16_t*)(ws + WS_YB + BRSZ) : (bf16_t*)(ws + WS_BR + 2 * BRSZ);
        for (int i = tid; i < 8704; i += 512) ((LAS unsigned*)STs)[i] = 0u;
        for (int i = tid; i < 2304; i += 512) ((LAS unsigned*)Att)[i] = 0u;
        f32x4 ST[8];
#pragma unroll
        for (int i = 0; i < 8; ++i) ST[i] = (f32x4){0.f, 0.f, 0.f, 0.f};
        u32x4 ldv[6]; f32x4 lda = (f32x4){0.f, 0.f, 0.f, 0.f};
        float wg[16];
#pragma unroll
        for (int r = 0; r < 16; ++r) wg[r] = p->in[24][((size_t)((l * 2 + d) * 16 + r)) * 512 + head * 128 + kch];
        const float bgk = p->in[25][(size_t)(l * 2 + d) * 512 + head * 128 + kch];
#define GC_LOAD(chunk) do { const int row = step_row(b, d, (chunk) * 64 + lane, colmajor); const bf16_t* rp = R + (size_t)row * 3328; \
            ldv[0] = *(const u32x4*)(rp + head * 128 + wid * 8); ldv[1] = *(const u32x4*)(rp + head * 128 + 64 + wid * 8); \
            ldv[2] = *(const u32x4*)(rp + 512 + head * 128 + wid * 8); ldv[3] = *(const u32x4*)(rp + 512 + head * 128 + 64 + wid * 8); \
            ldv[4] = *(const u32x4*)(rp + 1024 + head * 256 + vh * 128 + wid * 8); ldv[5] = *(const u32x4*)(rp + 1024 + head * 256 + vh * 128 + 64 + wid * 8); \
            if (tid < 256) { const int rowa = step_row(b, d, (chunk) * 64 + (tid >> 2), colmajor); lda = *(const f32x4*)(ALS + (size_t)rowa * 32 + d * 16 + (tid & 3) * 4); } } while (0)
#define GC_STORE() do { \
            _Pragma("unroll") for (int j = 0; j < 2; ++j) { const int c0 = (wid + 8 * j) * 8; \
                *(LAS u32x4*)(Qin + lane * 136 + c0) = ldv[j]; *(LAS u32x4*)(Kin + lane * 136 + c0) = ldv[2 + j]; \
                const unsigned wv[4] = {ldv[4 + j].x, ldv[4 + j].y, ldv[4 + j].z, ldv[4 + j].w}; \
                _Pragma("unroll") for (int e = 0; e < 8; ++e) VT[(c0 + e) * 72 + lane] = (bf16_t)((e & 1) ? (wv[e >> 1] >> 16) : (wv[e >> 1] & 0xffffu)); } \
            if (tid < 256) *(LAS f32x4*)(als + (tid >> 2) * 16 + (tid & 3) * 4) = lda; } while (0)
        GC_LOAD(0); GC_STORE();
        __syncthreads();
        for (int c = 0; c < 36; ++c) {
            if (c + 1 < 36) GC_LOAD(c + 1);
            { float lav[16]; float run = 0.f;
#pragma unroll
              for (int i = 0; i < 16; ++i) { const LAS float* ap = als + (seg * 16 + i) * 16;
                  const f32x4 a0 = *(const LAS f32x4*)ap, a1 = *(const LAS f32x4*)(ap + 4), a2 = *(const LAS f32x4*)(ap + 8), a3 = *(const LAS f32x4*)(ap + 12);
                  float z = bgk;
#pragma unroll
                  for (int r = 0; r < 4; ++r) z += a0[r] * wg[r] + a1[r] * wg[4 + r] + a2[r] * wg[8 + r] + a3[r] * wg[12 + r];
                  run += (fminf(z, 0.f) - __logf(1.f + __expf(-fabsf(z)))) * (1.f / 16.f); lav[i] = run; }
              tot[seg * 128 + kch] = run;
              __syncthreads();
              float off = 0.f, bl = 0.f;
#pragma unroll
              for (int s2 = 0; s2 < 4; ++s2) { const float t_ = tot[s2 * 128 + kch]; bl += t_; if (s2 < seg) off += t_; }
              if (seg == 0) blast[kch] = bl;
              float kst[16];
              const float ebl = __expf(bl);
#pragma unroll
              for (int i = 0; i < 16; ++i) { const int o_ = (seg * 16 + i) * 136 + kch; kst[i] = bf2f(Kin[o_]); lav[i] = off + lav[i]; }
              float qraw[16];
#pragma unroll
              for (int i = 0; i < 16; ++i) qraw[i] = bf2f(Qin[(seg * 16 + i) * 136 + kch]);
#pragma unroll
              for (int i = 0; i < 16; ++i) { const float e1 = __expf(lav[i]), e2 = __builtin_amdgcn_rcpf(e1);
                  qraw[i] *= 0.08838834764831845f * e1; kst[i] *= e2; }
#pragma unroll
              for (int i = 0; i < 16; ++i) { const int o_ = (seg * 16 + i) * 136 + kch; Qin[o_] = f2bf(qraw[i]); Kin[o_] = f2bf(kst[i]); kst[i] *= ebl; }
              { float f0[8], f1[8];
#pragma unroll
                for (int e = 0; e < 8; ++e) { f0[e] = kst[e]; f1[e] = kst[8 + e]; }
                *(LAS u32x4*)(KstT + kch * 72 + seg * 16) = pack8(f0); *(LAS u32x4*)(KstT + kch * 72 + seg * 16 + 8) = pack8(f1); } }
            __syncthreads();
            { const int lt = wid >> 1;
#pragma unroll
              for (int t2 = 0; t2 < 2; ++t2) { const int st = (wid & 1) * 2 + t2;
                  if (st <= lt) {
                      f32x4 acc = (f32x4){0.f, 0.f, 0.f, 0.f};
                      acc = mma16(Kin, 136, st * 16, Qin, 136, lt * 16, 4, acc, lane);
                      const int l_ = lt * 16 + r16, s0_ = st * 16 + quad * 4;
                      u32x2 w; w.x = cvt_pk_bf16((s0_ <= l_) ? acc[0] : 0.f, (s0_ + 1 <= l_) ? acc[1] : 0.f); w.y = cvt_pk_bf16((s0_ + 2 <= l_) ? acc[2] : 0.f, (s0_ + 3 <= l_) ? acc[3] : 0.f);
                      *(LAS u32x2*)(Att + l_ * 72 + s0_) = w; } } }
            __syncthreads();
            { const int lt = wid & 3, vt0 = (wid >> 2) * 4;
              bf16x8 bq[4], ba_[2];
#pragma unroll
              for (int kk = 0; kk < 4; ++kk) bq[kk] = *(const LAS bf16x8*)(Qin + (lt * 16 + r16) * 136 + kk * 32 + quad * 8);
#pragma unroll
              for (int kk = 0; kk < 2; ++kk) ba_[kk] = *(const LAS bf16x8*)(Att + (lt * 16 + r16) * 72 + kk * 32 + quad * 8);
              const int row = step_row(b, d, c * 64 + lt * 16 + r16, colmajor);
              bf16_t* op = O + (size_t)row * DM + head * 256 + vh * 128 + vt0 * 16 + quad * 4;
#pragma unroll
              for (int i = 0; i < 4; ++i) { f32x4 a = (f32x4){0.f, 0.f, 0.f, 0.f};
#pragma unroll
                  for (int kk = 0; kk < 2; ++kk) a = __builtin_amdgcn_mfma_f32_16x16x32_bf16(*(const LAS bf16x8*)(VT + ((vt0 + i) * 16 + r16) * 72 + kk * 32 + quad * 8), ba_[kk], a, 0, 0, 0);
#pragma unroll
                  for (int kk = 0; kk < 4; ++kk) a = __builtin_amdgcn_mfma_f32_16x16x32_bf16(*(const LAS bf16x8*)(STs + ((vt0 + i) * 16 + r16) * 136 + kk * 32 + quad * 8), bq[kk], a, 0, 0, 0);
                  u32x2 w; w.x = cvt_pk_bf16(a[0], a[1]); w.y = cvt_pk_bf16(a[2], a[3]);
                  *(u32x2*)(op + i * 16) = w; } }
            __syncthreads();
            {
#pragma unroll
              for (int kt = 0; kt < 8; ++kt) ST[kt] = ST[kt] * __expf(blast[kt * 16 + r16]);
              bf16x8 av_[2];
#pragma unroll
              for (int kk = 0; kk < 2; ++kk) av_[kk] = *(const LAS bf16x8*)(VT + (wid * 16 + r16) * 72 + kk * 32 + quad * 8);
#pragma unroll
              for (int kt = 0; kt < 8; ++kt) {
#pragma unroll
                  for (int kk = 0; kk < 2; ++kk) ST[kt] = __builtin_amdgcn_mfma_f32_16x16x32_bf16(av_[kk], *(const LAS bf16x8*)(KstT + (kt * 16 + r16) * 72 + kk * 32 + quad * 8), ST[kt], 0, 0, 0); }
#pragma unroll
              for (int kt = 0; kt < 8; ++kt)
#pragma unroll
                  for (int j = 0; j < 4; ++j) STs[(wid * 16 + quad * 4 + j) * 136 + kt * 16 + r16] = f2bf(ST[kt][j]); }
            __syncthreads();
            if (c + 1 < 36) GC_STORE();
            __syncthreads();
        }
#undef GC_LOAD
#undef GC_STORE
    }
}

__device__ __forceinline__ void phase_gla_combine(KP p, int l) {
    unsigned char* const ws = ows(p); const int BID_ = obid(), GRD_ = ogrid(); (void)ws; (void)BID_; (void)GRD_;
    const int tid_ = otid(); const int gw = BID_ * 8 + (tid_ >> 6), GW = GRD_ * 8, lane = tid_ & 63;
    const bf16_t* R = (const bf16_t*)(ws + WS_R);
    bf16_t* BR2 = (bf16_t*)(ws + WS_BR + 2 * BRSZ); const bf16_t* OB = (const bf16_t*)(ws + WS_YB + BRSZ);
    const f32x4 ng = *(const f32x4*)(p->in[26] + (size_t)l * 256 + lane * 4);
    for (int rp = gw; rp < TT / 2; rp += GW) {
        f32x4 o[2][4]; u32x2 gz[2][4];
#pragma unroll
        for (int r = 0; r < 2; ++r) { const int row = rp * 2 + r;
#pragma unroll
            for (int j = 0; j < 4; ++j) { const int col = j * 256 + lane * 4;
                const u32x2 f = __builtin_nontemporal_load((const u32x2*)(BR2 + (size_t)row * DM + col)), bk = __builtin_nontemporal_load((const u32x2*)(OB + (size_t)row * DM + col));
                gz[r][j] = __builtin_nontemporal_load((const u32x2*)(R + (size_t)row * 3328 + 2048 + col));
                o[r][j] = (f32x4){bflo(f.x) + bflo(bk.x), bfhi(f.x) + bfhi(bk.x), bflo(f.y) + bflo(bk.y), bfhi(f.y) + bfhi(bk.y)}; } }
        float qq[2][4];
#pragma unroll
        for (int r = 0; r < 2; ++r)
#pragma unroll
            for (int j = 0; j < 4; ++j) qq[r][j] = wave_sum(o[r][j][0] * o[r][j][0] + o[r][j][1] * o[r][j][1] + o[r][j][2] * o[r][j][2] + o[r][j][3] * o[r][j][3], lane);
#pragma unroll
        for (int r = 0; r < 2; ++r) { const int row = rp * 2 + r;
#pragma unroll
            for (int j = 0; j < 4; ++j) { const int col = j * 256 + lane * 4;
                const float rstd = rsqrtf(qq[r][j] * (1.f / 256.f) + EPS);
                u32x2 w; w.x = cvt_pk_bf16(o[r][j][0] * rstd * ng[0] * silu(bflo(gz[r][j].x)), o[r][j][1] * rstd * ng[1] * silu(bfhi(gz[r][j].x)));
                w.y = cvt_pk_bf16(o[r][j][2] * rstd * ng[2] * silu(bflo(gz[r][j].y)), o[r][j][3] * rstd * ng[3] * silu(bfhi(gz[r][j].y)));
                *(u32x2*)(BR2 + (size_t)row * DM + col) = w; } }
    }
}
#define p kparams()
#define G ogrid()
#define bid obid()
#define U ((bf16_t*)(ows(p) + WS_U))
#define R ((bf16_t*)(ows(p) + WS_R))
#define YB ((float*)(ows(p) + WS_YB))
#define BR ((bf16_t*)(ows(p) + WS_BR))
#define WUP ((const bf16_t*)(ows(p) + WS_WUP))
#define WDN ((const bf16_t*)(ows(p) + WS_WDN))
#define WIN ((const bf16_t*)(ows(p) + WS_WIN))
#define WBR ((const bf16_t*)(ows(p) + WS_WBR))
#define WOUT ((const bf16_t*)(ows(p) + WS_WOUT))
#define WLRU ((const bf16_t*)(ows(p) + WS_WLRU))
#define xst ((volatile LAS unsigned*)((LAS unsigned char*)shm + 131072))
#define GSYNC() xcd_barrier((unsigned*)(ows(p) + WS_BAR), xst)
#undef xst
#define xst ((volatile LAS unsigned*)(lds + 131072))
#ifndef REP_GEMM
#define REP_GEMM 1
#endif
#ifndef REP_SCAN
#define REP_SCAN 1
#endif
#ifndef REP_LIGHT
#define REP_LIGHT 1
#endif
__device__ __forceinline__ void layer_half(const int l, const int f, LAS unsigned char* lds) {
    pg8::StaticOrder S;
    const int MR = (l == DEPTH - 1) ? TL : TT;
            if (f == 1) {
                { pg8::Gemm g{U, WIN, TT, 3328, 1024, 1024, 1024, 0}; S.init(TT, 3328, G, bid);
                  pg8::EpiBf16Side E{R, 3328, (float*)(ows(p) + WS_DTS), 3072}; for (int rep_ = 0; rep_ < REP_GEMM; ++rep_) pg8::gemm_phase(lds, g, S, E); }
                GSYNC();
                for (int rep_ = 0; rep_ < REP_LIGHT; ++rep_) phase_ssd_conv(p, l);
                GSYNC();
                for (int rep_ = 0; rep_ < REP_SCAN; ++rep_) phase_ssd_chunk(p, l, lds);
                GSYNC();
                for (int rep_ = 0; rep_ < REP_LIGHT; ++rep_) phase_ssd_combine(p, l);
                { pg8::Gemm g{U, WIN + (size_t)3104 * 1024, TT, 2048, 1024, 1024, 1024, 0}; S.init(TT, 2048, G, bid);
                  pg8::EpiBf16Side E{(bf16_t*)YB, 2048, nullptr, -1}; for (int rep_ = 0; rep_ < REP_GEMM; ++rep_) pg8::gemm_phase(lds, g, S, E); }
                GSYNC();
                phase_lru_fused(p, l, lds);
                GSYNC();
                { pg8::Gemm g{U, WIN + (size_t)5152 * 1024, TT, 3328, 1024, 1024, 1024, 0}; S.init(TT, 3328, G, bid);
                  pg8::EpiBf16Side E{R, 3328, (float*)(ows(p) + WS_ALS), 3072}; for (int rep_ = 0; rep_ < REP_GEMM; ++rep_) pg8::gemm_phase(lds, g, S, E); }
                GSYNC();
                for (int rep_ = 0; rep_ < REP_SCAN; ++rep_) phase_gla_chunk(p, l, lds);
                GSYNC();
                phase_gla_combine(p, l);
                GSYNC();
                { pg8::Gemm g{U, WIN + (size_t)8256 * 1024, MR, 3072, 1024, 1024, 1024, 0}; S.init(MR, 3072, G, bid);
                  pg8::EpiBf16Side E{R, 3072, nullptr, -1}; for (int rep_ = 0; rep_ < REP_GEMM; ++rep_) pg8::gemm_phase(lds, g, S, E); }
                GSYNC();
                S.init(MR, 1024, G, bid);
                { pg8::Gemm g{BR, WBR, MR, 1024, 1024, 1024, 1024, 0}; pg8::EpiMerge<0> E{R, (bf16_t*)YB, U}; pg8::gemm_phase(lds, g, S, E); }
                { pg8::Gemm g{BR + (size_t)TT * DM, WBR + (size_t)1024 * 1024, MR, 1024, 1024, 1024, 1024, 0}; pg8::EpiMerge<1> E{R, (bf16_t*)YB, U}; pg8::gemm_phase(lds, g, S, E); }
                { pg8::Gemm g{BR + 2 * (size_t)TT * DM, WBR + (size_t)2 * 1024 * 1024, MR, 1024, 1024, 1024, 1024, 0}; pg8::EpiMerge<2> E{R, (bf16_t*)YB, U}; pg8::gemm_phase(lds, g, S, E); }
                GSYNC();
                { pg8::Gemm g{U, WOUT, MR, 1024, 1024, 1024, 1024, 0}; S.init(MR, 1024, G, bid);
                  pg8::EpiBf16Side E{(bf16_t*)YB, 1024, nullptr, -1}; for (int rep_ = 0; rep_ < REP_GEMM; ++rep_) pg8::gemm_phase(lds, g, S, E); }
                GSYNC();
                phase_ln(p, l, 5, 1.0f, 1, l, 6, MR);
                GSYNC();
            }
            { const int MF = f ? MR : TT; pg8::Gemm g{U, WUP + (size_t)f * 5632 * 1024, MF, 5632, 1024, 1024, 1024, 0}; S.init(MF, 5632, G, bid);
              pg8::EpiSwiglu E{R}; for (int rep_ = 0; rep_ < REP_GEMM; ++rep_) pg8::gemm_phase(lds, g, S, E); }
            GSYNC();
            { const int MF = f ? MR : TT; pg8::Gemm g{R, WDN + (size_t)f * 1024 * 2816, MF, 1024, 2816, 2816, 2816, 0}; S.init(MF, 1024, G, bid);
              pg8::EpiBf16Side E{(bf16_t*)YB, 1024, nullptr, -1}; for (int rep_ = 0; rep_ < REP_GEMM; ++rep_) pg8::gemm_phase(lds, g, S, E); }
            GSYNC();
            if (f == 0) phase_ln(p, l, 2, 0.5f, 0, l, 3, TT);
            else { phase_ln(p, l, 8, 0.5f, 2, l + 1 < DEPTH ? l + 1 : -1, 0, MR); if (l + 1 < DEPTH) for (int rep_ = 0; rep_ < REP_LIGHT; ++rep_) phase_convert(p, l + 1, lds); }
            GSYNC();
}
__global__ void __launch_bounds__(512, 2) mega(Params p_arg) {
    extern __shared__ __attribute__((aligned(16))) unsigned char shm[];
    LAS unsigned char* lds = (LAS unsigned char*)shm;
    cg::grid_group grid = cg::this_grid();
    pg8::StaticOrder S;
    if (threadIdx.x == 0) { xst[0] = 0u; xst[1] = 0u; }
    __syncthreads();
    if (threadIdx.x == 0) (void)xb_add(&((unsigned*)(p->ws + WS_BAR))[XB_XCNT(xb_xcc_id())], 1u);

    phase_mods(p, lds);
    phase_convert(p, 0, lds);
    if (p->ws == nullptr) grid.sync();
    GSYNC();
    phase_init(p);
    GSYNC();

    layer_half(0, 0, lds); layer_half(0, 1, lds);
    layer_half(1, 0, lds); layer_half(1, 1, lds);
    layer_half(2, 0, lds); layer_half(2, 1, lds);
    layer_half(3, 0, lds); layer_half(3, 1, lds);
}

#undef GSYNC
#undef xst
#undef p
#undef G
#undef bid
#undef U
#undef R
#undef YB
#undef BR
#undef WUP
#undef WDN
#undef WIN
#undef WBR
#undef WOUT
#undef WLRU
extern "C" void kernel_launch(void* const* d_in, const int* in_sizes, int n_in, void* d_out, int out_size, void* d_ws, size_t ws_size, hipStream_t stream) {
    constexpr int LDS_BYTES = pg8::STAGE_BYTES + 16;
    static int grid = 0;
    if (grid == 0) {
        if (n_in != 29 || ws_size < WS_END) { fprintf(stderr, "kernel_launch: unexpected n_in %d / ws_size %zu (need %zu)\n", n_in, ws_size, (size_t)WS_END); grid = -1; return; }
        int dev = 0, cus = 0, per_cu = 0;
        hipGetDevice(&dev);
        hipDeviceGetAttribute(&cus, hipDeviceAttributeMultiprocessorCount, dev);
        if (hipFuncSetAttribute((const void*)mega, hipFuncAttributeMaxDynamicSharedMemorySize, LDS_BYTES) != hipSuccess) { fprintf(stderr, "kernel_launch: hipFuncSetAttribute failed\n"); grid = -1; return; }
        if (hipOccupancyMaxActiveBlocksPerMultiprocessor(&per_cu, (const void*)mega, 512, LDS_BYTES) != hipSuccess || per_cu < 1) { fprintf(stderr, "kernel_launch: occupancy query failed (%d)\n", per_cu); per_cu = 1; }
        (void)hipGetLastError();
        grid = cus * 1;
        fprintf(stderr, "kernel_launch: grid %d (cus %d, per_cu %d)\n", grid, cus, per_cu);
    }
    if (grid < 0) return;
    if (hipMemsetAsync((unsigned char*)d_ws + WS_BAR, 0, (size_t)XCD_BAR_WORDS_C * 4, stream) != hipSuccess) { fprintf(stderr, "kernel_launch: barrier memset failed\n"); return; }
    Params p{};
    for (int i = 0; i < 29; ++i) p.in[i] = (const float*)d_in[i];
    p.out = (float*)d_out; p.ws = (unsigned char*)d_ws;
    void* args[] = {&p};
    hipError_t e = hipLaunchCooperativeKernel((const void*)mega, dim3(grid), dim3(512), args, LDS_BYTES, stream);
    if (e != hipSuccess) fprintf(stderr, "kernel_launch: cooperative launch failed: %s (grid %d)\n", hipGetErrorString(e), grid);
}
```
